# Optimizing an MI355X kernel written in HIP

```python
import jax, jax.numpy as jnp
from jax import lax
import numpy as np

D_MODEL = 1024
BATCH = 8
SEQ = 2048
DEPTH = 1

D_CONV = 1024
CONV_W = 3
N_HEADS = 16
HEAD_DIM = 64
N_KV = 4
GROUP = N_HEADS // N_KV
D_ATT = N_HEADS * HEAD_DIM
D_KV = N_KV * HEAD_DIM
CMP_LEN = 32
CMP_STRIDE = 16
CMP_HID = 128
SLC_LEN = 64
N_SEL = 8
WINDOW = 512
Q_BLOCK = 64
N_MIXERS = 2
NORM_EPS = 1e-6

SPLITS = (D_CONV, D_CONV, D_CONV, D_CONV,
          D_ATT,
          D_KV, D_KV, D_KV, D_KV, D_KV, D_KV,
          3 * N_HEADS,
          D_ATT,
          N_MIXERS * D_MODEL)
N_IN = 4 * D_CONV + 2 * D_ATT + 6 * D_KV + 3 * N_HEADS + N_MIXERS * D_MODEL

kernel_name = "hybrid_shortconv_nsa_gated_merge"


def rmsnorm(x, w):
    xf = x.astype(jnp.float32)
    r = lax.rsqrt(jnp.mean(xf * xf, axis=-1, keepdims=True) + NORM_EPS)
    return (xf * r).astype(x.dtype) * w


def alibi_slopes():
    return jnp.exp2(-8.0 * jnp.arange(1, N_HEADS + 1, dtype=jnp.float32) / N_HEADS)


def masked_softmax(s, mask):
    s = jnp.where(mask, s.astype(jnp.float32), -jnp.inf)
    m = jnp.max(s, axis=-1, keepdims=True)
    m = jnp.where(jnp.isfinite(m), m, 0.0)
    e = jnp.where(mask, jnp.exp(s - m), 0.0)
    return e / jnp.maximum(jnp.sum(e, axis=-1, keepdims=True), 1e-30)


def short_conv_mixer(h, b_gate, c_gate, z, conv_w, conv_b):
    u = c_gate * h
    T = u.shape[1]
    up = jnp.pad(u, ((0, 0), (CONV_W - 1, 0), (0, 0)))
    y = conv_b + conv_w[0] * up[:, 0:T] + conv_w[1] * up[:, 1:T + 1] + conv_w[2] * up[:, 2:T + 2]
    return b_gate * y * jax.nn.silu(z)


def compress_blocks(k, pe, w1, w2):
    B, G, T, dh = k.shape
    kd = k.reshape(B, G, T // CMP_STRIDE, CMP_STRIDE, dh)
    blocks = jnp.concatenate([kd[:, :, :-1], kd[:, :, 1:]], axis=3)
    blocks = (blocks + pe).reshape(B, G, blocks.shape[2], CMP_LEN * dh)
    return jax.nn.silu(blocks @ w1) @ w2


def nsa_attention(q, k_cmp, v_cmp, k_slc, v_slc, k_win, v_win, gates,
                  pe_k, pe_v, w1_k, w2_k, w1_v, w2_v):
    B, T = q.shape[0], q.shape[1]
    f32 = jnp.float32
    q = (q * HEAD_DIM ** -0.5).reshape(B, T, N_KV, GROUP, HEAD_DIM).transpose(0, 2, 3, 1, 4)
    tr = lambda a: a.transpose(0, 2, 1, 3)
    slopes = alibi_slopes().reshape(N_KV, GROUP)[None, :, :, None, None]
    t_pos = jnp.arange(T)

    kc = compress_blocks(tr(k_cmp), pe_k, w1_k, w2_k)
    vc = compress_blocks(tr(v_cmp), pe_v, w1_v, w2_v)
    n_cmp = kc.shape[2]
    c_start = jnp.arange(n_cmp) * CMP_STRIDE
    c_end = c_start + CMP_LEN - 1
    dist_c = t_pos[:, None] - c_end[None, :]
    s_c = jnp.einsum('bgrtd,bgcd->bgrtc', q, kc) - slopes * dist_c.astype(f32)
    p_cmp = masked_softmax(s_c, dist_c >= 0)
    o_cmp = jnp.einsum('bgrtc,bgcd->bgrtd', p_cmp.astype(vc.dtype), vc)

    n_slc = T // SLC_LEN
    s_start = jnp.arange(n_slc) * SLC_LEN
    overlap = ((c_start[:, None] <= s_start[None, :] + SLC_LEN - 1)
               & (c_end[:, None] >= s_start[None, :])).astype(f32)
    imp = jnp.einsum('bgrtc,cj->bgtj', p_cmp, overlap)
    cur = (t_pos // SLC_LEN)[:, None]
    j = jnp.arange(n_slc)[None, :]
    forced = (j == 0) | (j == cur) | (j == cur - 1)
    imp = jnp.where(forced, jnp.inf, jnp.where(j <= cur, imp, -jnp.inf))
    n_top = min(N_SEL, n_slc)
    top_val, top_idx = lax.top_k(imp, n_top)
    top_ok = top_val > -jnp.inf

    ks_blocks = tr(k_slc).reshape(B, N_KV, n_slc, SLC_LEN, HEAD_DIM)
    vs_blocks = tr(v_slc).reshape(B, N_KV, n_slc, SLC_LEN, HEAD_DIM)
    kw = jnp.pad(tr(k_win), ((0, 0), (0, 0), (WINDOW, 0), (0, 0)))
    vw = jnp.pad(tr(v_win), ((0, 0), (0, 0), (WINDOW, 0), (0, 0)))
    gather = jax.vmap(jax.vmap(lambda blk, ix: blk[ix]))
    n_sel_keys = n_top * SLC_LEN

    def block_fn(i):
        t0 = i * Q_BLOCK
        qb = lax.dynamic_slice_in_dim(q, t0, Q_BLOCK, axis=3)
        tq = t0 + jnp.arange(Q_BLOCK)
        ix = lax.dynamic_slice_in_dim(top_idx, t0, Q_BLOCK, axis=2)
        ok = lax.dynamic_slice_in_dim(top_ok, t0, Q_BLOCK, axis=2)
        ks = gather(ks_blocks, ix).reshape(B, N_KV, Q_BLOCK, n_sel_keys, HEAD_DIM)
        vs = gather(vs_blocks, ix).reshape(B, N_KV, Q_BLOCK, n_sel_keys, HEAD_DIM)
        s_pos = (ix[..., None] * SLC_LEN + jnp.arange(SLC_LEN)).reshape(B, N_KV, Q_BLOCK, n_sel_keys)
        s_ok = jnp.repeat(ok, SLC_LEN, axis=-1)
        d_s = tq[:, None] - s_pos
        s_s = jnp.einsum('bgrqd,bgqkd->bgrqk', qb, ks) - slopes * d_s[:, :, None].astype(f32)
        p_s = masked_softmax(s_s, (s_ok & (d_s >= 0))[:, :, None])
        o_s = jnp.einsum('bgrqk,bgqkd->bgrqd', p_s.astype(vs.dtype), vs)
        kwb = lax.dynamic_slice_in_dim(kw, t0, Q_BLOCK + WINDOW, axis=2)
        vwb = lax.dynamic_slice_in_dim(vw, t0, Q_BLOCK + WINDOW, axis=2)
        w_pos = t0 - WINDOW + jnp.arange(Q_BLOCK + WINDOW)
        d_w = tq[:, None] - w_pos[None, :]
        s_w = jnp.einsum('bgrqd,bgkd->bgrqk', qb, kwb) - slopes * d_w.astype(f32)
        p_w = masked_softmax(s_w, (d_w >= 0) & (d_w < WINDOW) & (w_pos[None, :] >= 0))
        o_w = jnp.einsum('bgrqk,bgkd->bgrqd', p_w.astype(vwb.dtype), vwb)
        return o_s, o_w

    o_slc, o_win = lax.map(block_fn, jnp.arange(T // Q_BLOCK))
    unblock = lambda o: o.transpose(1, 2, 3, 0, 4, 5).reshape(B, N_KV, GROUP, T, HEAD_DIM)
    o = jnp.stack([o_cmp, unblock(o_slc), unblock(o_win)], axis=-1)
    o = o.transpose(0, 3, 1, 2, 4, 5).reshape(B, T, N_HEADS, HEAD_DIM, 3)
    return jnp.einsum('bthdc,bthc->bthd', o, gates).reshape(B, T, D_ATT)


def setup_inputs(seed: int = 0) -> dict:
    key = jax.random.key(seed)
    ks = jax.random.split(key, 16)
    nrm = lambda k, shape, scale: jax.random.normal(k, shape, jnp.float32) * scale
    return {
        "x": nrm(ks[0], (BATCH, SEQ, D_MODEL), 1.0),
        "norm_w": 1.0 + nrm(ks[1], (DEPTH, D_MODEL), 0.02),
        "w_in": nrm(ks[2], (DEPTH, D_MODEL, N_IN), D_MODEL ** -0.5),
        "conv_w": nrm(ks[3], (DEPTH, CONV_W, D_CONV), CONV_W ** -0.5),
        "conv_b": nrm(ks[4], (DEPTH, D_CONV), 0.02),
        "cmp_pe_k": nrm(ks[5], (DEPTH, CMP_LEN, HEAD_DIM), 0.1),
        "cmp_pe_v": nrm(ks[6], (DEPTH, CMP_LEN, HEAD_DIM), 0.1),
        "cmp_w1_k": nrm(ks[7], (DEPTH, CMP_LEN * HEAD_DIM, CMP_HID), (CMP_LEN * HEAD_DIM) ** -0.5),
        "cmp_w2_k": nrm(ks[8], (DEPTH, CMP_HID, HEAD_DIM), CMP_HID ** -0.5),
        "cmp_w1_v": nrm(ks[9], (DEPTH, CMP_LEN * HEAD_DIM, CMP_HID), (CMP_LEN * HEAD_DIM) ** -0.5),
        "cmp_w2_v": nrm(ks[10], (DEPTH, CMP_HID, HEAD_DIM), CMP_HID ** -0.5),
        "w_proj_a": nrm(ks[11], (DEPTH, D_CONV, D_MODEL), D_CONV ** -0.5),
        "w_proj_b": nrm(ks[12], (DEPTH, D_ATT, D_MODEL), D_ATT ** -0.5),
        "w_out": nrm(ks[13], (DEPTH, D_MODEL, D_MODEL), D_MODEL ** -0.5),
        "final_norm_w": 1.0 + nrm(ks[14], (D_MODEL,), 0.02),
    }


def reference(x, norm_w, w_in, conv_w, conv_b, cmp_pe_k, cmp_pe_v, cmp_w1_k, cmp_w2_k,
              cmp_w1_v, cmp_w2_v, w_proj_a, w_proj_b, w_out, final_norm_w):
    B, T, _ = x.shape
    offsets = np.cumsum(SPLITS)[:-1].tolist()
    for l in range(DEPTH):
        h = rmsnorm(x, norm_w[l])
        proj = h @ w_in[l]
        (h_a, b_a, c_a, z_a, q, k_c, v_c, k_s, v_s, k_w, v_w,
         g_nsa, z_b, g_mix) = jnp.split(proj, offsets, axis=-1)
        y_a = short_conv_mixer(h_a, b_a, c_a, z_a, conv_w[l], conv_b[l]) @ w_proj_a[l]
        kv = lambda a: a.reshape(B, T, N_KV, HEAD_DIM)
        o_b = nsa_attention(q.reshape(B, T, N_HEADS, HEAD_DIM), kv(k_c), kv(v_c), kv(k_s), kv(v_s),
                            kv(k_w), kv(v_w), jax.nn.sigmoid(g_nsa).reshape(B, T, N_HEADS, 3),
                            cmp_pe_k[l], cmp_pe_v[l], cmp_w1_k[l], cmp_w2_k[l], cmp_w1_v[l], cmp_w2_v[l])
        y_b = (o_b * jax.nn.silu(z_b)) @ w_proj_b[l]
        g = jax.nn.sigmoid(g_mix).reshape(B, T, N_MIXERS, D_MODEL)
        mixed = g[:, :, 0] * y_a + g[:, :, 1] * y_b
        x = x + mixed @ w_out[l]
    return rmsnorm(x, final_norm_w)
```

```cpp
#include <hip/hip_runtime.h>
#include <hip/hip_cooperative_groups.h>
#include <cstdio>
#include <cstdint>
namespace cg = cooperative_groups;

#define LAS __attribute__((address_space(3)))
typedef unsigned short bf16_t;
typedef short bf16x8 __attribute__((ext_vector_type(8)));
typedef short s16x4 __attribute__((ext_vector_type(4)));
typedef float f32x2 __attribute__((ext_vector_type(2)));
typedef float f32x4 __attribute__((ext_vector_type(4)));
typedef float f32x16 __attribute__((ext_vector_type(16)));
typedef unsigned u32x2 __attribute__((ext_vector_type(2)));
typedef unsigned u32x4 __attribute__((ext_vector_type(4)));
typedef __bf16 bf16x2_t __attribute__((ext_vector_type(2)));

constexpr int NB = 8, T = 2048, D = 1024, M = NB * T;
constexpr int NIN = 9776, NPAD = 9984;
constexpr float NORM_EPS = 1e-6f;
constexpr float LOG2E = 1.4426950408889634f;
constexpr float QSCALE = 0.125f * LOG2E;

constexpr size_t MiB = 1u << 20;
constexpr size_t WS_UC = 1 * MiB;
constexpr size_t WS_WINT = 3 * MiB;
constexpr size_t WS_GATE = 33 * MiB;
constexpr size_t WS_Q = 65 * MiB;
constexpr size_t WS_KV = 97 * MiB;
constexpr size_t KVARR = (size_t)M * 256 * 2;
constexpr size_t WS_ZB = 145 * MiB;
constexpr size_t WS_G0 = 177 * MiB;
constexpr size_t WS_G1 = 209 * MiB;
constexpr size_t WS_GNSA = 241 * MiB;
constexpr size_t WS_KC = 244 * MiB;
constexpr size_t WS_VC = WS_KC + 512 * 1024;
constexpr size_t WS_WA = 245 * MiB, WS_WB = 247 * MiB, WS_WO = 249 * MiB;
constexpr size_t WS_W1S = 251 * MiB;
constexpr size_t WS_PEB = 253 * MiB;
constexpr size_t WS_X = 254 * MiB;
constexpr size_t WS_END = 255 * MiB;
constexpr size_t DO_BATCH = 8 * MiB, DO_PART = 4 * MiB;

constexpr int LDS_BYTES = 139264;

namespace pg8 {
constexpr int BM = 256, BK = 64, HALF = 128, HTB = HALF * BK * 2, STAGE_BYTES = 8 * HTB, NXCD = 8, WGM = 8;
__host__ __device__ __forceinline__ int lds_byte(int r, int c) { const int st = (r >> 4) * 2 + (c >> 5), rr = r & 15, cc = c & 31, ob = rr * 64 + cc * 2; return st * 1024 + (ob ^ (((ob >> 9) & 1) << 5)); }
__host__ __device__ __forceinline__ void stage_rc(int b, int& R, int& C) { const int st = b / 1024, sb = b % 1024, swz = sb ^ (((sb >> 9) & 1) << 5); R = (st >> 1) * 16 + swz / 64; C = (st & 1) * 32 + (swz % 64) / 2; }
__host__ __device__ __forceinline__ int perm32(int rho) { const int n = rho >> 4, i = rho & 15; return 8 * (i >> 2) + 4 * n + (i & 3); }

struct Unit { int pm, pn, aux; };
struct Gemm { const char* A; const char* Bt; int nt; unsigned a_row, b_row, a_half, b_half, a_k, b_k; };

struct StaticOrder {
    int nM, nN, nwg, G, c, i0, lim; size_t tA, tB, aHi;
    __device__ void init(int M_, int N_, int G_, int c_, size_t tA_, size_t tB_, size_t aHi_ = 0) { nM = M_ / BM; nN = N_ / BM; nwg = nM * nN; G = G_; c = c_; tA = tA_; tB = tB_; aHi = aHi_; i0 = 0; lim = nwg; }
    __device__ bool next(int i, Unit& u) const {
        const long L = (long)(i + i0) * G + c; if (L >= lim) return false;
        int wgid = (int)L; { const int q = nwg / NXCD, r = nwg % NXCD, xcd = wgid % NXCD, off = wgid / NXCD; wgid = (xcd < r ? xcd * (q + 1) : r * (q + 1) + (xcd - r) * q) + off; }
        const int nig = WGM * nN, gid = wgid / nig, fm = gid * WGM, gsz = (nM - fm) < WGM ? (nM - fm) : WGM;
        u.pm = fm + ((wgid % nig) % gsz); u.pn = (wgid % nig) / gsz; u.aux = 0; return true;
    }
    __device__ __forceinline__ size_t offA(const Unit& u) const { return aHi ? (size_t)(u.pm >> 3) * aHi + (size_t)(u.pm & 7) * tA : (size_t)u.pm * tA; }
    __device__ __forceinline__ size_t offB(const Unit& u) const { return (size_t)u.pn * tB; }
};

struct PairOrder {
    StaticOrder so; size_t a0, a1, b0, b1;
    __device__ bool next(int i, Unit& u) const { if (!so.next(i >> 1, u)) return false; u.aux = i & 1; return true; }
    __device__ __forceinline__ size_t offA(const Unit& u) const { return (u.aux ? a1 : a0) + (size_t)u.pm * so.tA; }
    __device__ __forceinline__ size_t offB(const Unit& u) const { return (u.aux ? b1 : b0) + (size_t)u.pn * so.tB; }
};
struct CmpOrder {
    int G, c;
    __device__ bool next(int i, Unit& u) const {
        const int L = i * G + c; if (L >= 64) return false;
        const int b = L & 7, idx = L >> 3; u.aux = idx >> 2; u.pn = (idx >> 1) & 1; u.pm = b * 2 + (idx & 1); return true;
    }
    __device__ __forceinline__ size_t offA(const Unit& u) const { return (size_t)u.aux * KVARR + (size_t)(u.pm >> 1) * (2048u * 512u) + (size_t)(u.pm & 1) * 256u + (size_t)u.pn * 8192u; }
    __device__ __forceinline__ size_t offB(const Unit& u) const { return (size_t)u.aux * (128u * 4096u) + (size_t)u.pn * 2048u; }
};

template <class Epi, class Sched, bool ALIGN_EPI>
__device__ __forceinline__ void gemm_phase(LAS unsigned char* lds, const Gemm g, const Sched& S, const Epi& E) {
    const int tid = threadIdx.x, wid = __builtin_amdgcn_readfirstlane(tid >> 6), lane = tid & 63, wr = wid >> 2, wc = wid & 3, fr = lane & 15, fq = lane >> 4;
    const int nt = g.nt;
    unsigned voffA[2], voffB[2];
#pragma unroll
    for (int i = 0; i < 2; ++i) { int R, C; stage_rc(tid * 16 + i * 8192, R, C); const int Rb = Epi::PERM ? ((R & ~31) + perm32(R & 31)) : R;
        voffA[i] = (unsigned)R * g.a_row + (unsigned)C * 2u; voffB[i] = (unsigned)Rb * g.b_row + (unsigned)C * 2u; }
    const size_t kA = g.a_k, kB = g.b_k, hA = g.a_half, hB = g.b_half;
    const unsigned ldsw = (unsigned)wid * 1024u;
    const int aoff = lds_byte(wr * 64 + fr, fq * 8), boff = lds_byte(wc * 32 + fr, fq * 8);
#define PG8_SA(b, h) (((b) * 2 + (h)) * HTB)
#define PG8_SB(b, h) ((4 + (b) * 2 + (h)) * HTB)
#define PG8_STAGE(bufoff, gbase, voff) do { _Pragma("unroll") for (int _i = 0; _i < 2; ++_i) \
        __builtin_amdgcn_global_load_lds((const unsigned*)((const char*)(gbase) + (voff)[_i]), (LAS unsigned*)(lds + (bufoff) + ldsw + _i * 8192), 16, 0, 0); } while (0)
#define PG8_LDA(dst, b, h) do { _Pragma("unroll") for (int m = 0; m < 4; ++m) _Pragma("unroll") for (int k = 0; k < 2; ++k) dst[m][k] = *(const LAS bf16x8*)(lds + PG8_SA(b, h) + aoff + m * 2048 + k * 1024); } while (0)
#define PG8_LDB(dst, b, h) do { _Pragma("unroll") for (int n = 0; n < 2; ++n) _Pragma("unroll") for (int k = 0; k < 2; ++k) dst[n][k] = *(const LAS bf16x8*)(lds + PG8_SB(b, h) + boff + n * 2048 + k * 1024); } while (0)
#define PG8_MMA(ai, bj, At, Bt) do { __builtin_amdgcn_s_setprio(1); _Pragma("unroll") for (int m = 0; m < 4; ++m) _Pragma("unroll") for (int n = 0; n < 2; ++n) _Pragma("unroll") for (int k = 0; k < 2; ++k) \
        acc[ai][bj][m][n] = __builtin_amdgcn_mfma_f32_16x16x32_bf16(Bt[n][k], At[m][k], acc[ai][bj][m][n], 0, 0, 0); __builtin_amdgcn_s_setprio(0); } while (0)
#define PG8_WAIT_V(n) asm volatile("s_waitcnt vmcnt(" #n ")" ::: "memory")
#define PG8_WAIT_L(n) asm volatile("s_waitcnt lgkmcnt(" #n ")" ::: "memory")
#define PG8_BAR __builtin_amdgcn_s_barrier()
#define PG8_SCHED __builtin_amdgcn_sched_barrier(0)
    Unit cur, nxt; int ui = 0;
    if (!S.next(0, cur)) return;
    f32x4 acc[2][2][4][2];
#pragma unroll
    for (int a = 0; a < 2; ++a)
#pragma unroll
        for (int b = 0; b < 2; ++b)
#pragma unroll
            for (int m = 0; m < 4; ++m)
#pragma unroll
                for (int n = 0; n < 2; ++n) acc[a][b][m][n] = (f32x4){0.f, 0.f, 0.f, 0.f};
    bf16x8 At[4][2], B0[2][2], B1[2][2];
    const char* cA = g.A + S.offA(cur); const char* cB = g.Bt + S.offB(cur);
    PG8_STAGE(PG8_SB(0, 0), cB, voffB); PG8_STAGE(PG8_SB(0, 1), cB + hB, voffB); PG8_STAGE(PG8_SA(0, 0), cA, voffA); PG8_STAGE(PG8_SA(0, 1), cA + hA, voffA);
    if (wr == 1) PG8_BAR;
    PG8_WAIT_V(2); PG8_BAR;
    PG8_STAGE(PG8_SB(1, 0), cB + kB, voffB); PG8_STAGE(PG8_SA(1, 0), cA + kA, voffA); PG8_STAGE(PG8_SB(1, 1), cB + hB + kB, voffB);
    PG8_WAIT_V(6); PG8_BAR;
    for (;;) {
        const bool has_next = S.next(ui + 1, nxt);
        const char* nA = has_next ? g.A + S.offA(nxt) : cA; const char* nB = has_next ? g.Bt + S.offB(nxt) : cB;
        for (int t = 0; t < nt; t += 2) {
            const bool last = (t == nt - 2);
            const char* a1 = cA + (size_t)(t + 1) * kA;
            const char* a2 = last ? nA : cA + (size_t)(t + 2) * kA; const char* b2 = last ? nB : cB + (size_t)(t + 2) * kB;
            const char* a3 = a2 + kA; const char* b3 = b2 + kB;
            PG8_LDB(B0, 0, 0); PG8_LDB(B1, 0, 1); PG8_SCHED; PG8_LDA(At, 0, 0); PG8_STAGE(PG8_SA(1, 1), a1 + hA, voffA);
            PG8_WAIT_V(8); PG8_WAIT_L(0); PG8_BAR; PG8_MMA(0, 0, At, B0); PG8_MMA(0, 1, At, B1); PG8_BAR; PG8_SCHED;
            PG8_LDA(At, 0, 1); PG8_STAGE(PG8_SB(0, 0), b2, voffB); PG8_STAGE(PG8_SB(0, 1), b2 + hB, voffB); PG8_STAGE(PG8_SA(0, 0), a2, voffA);
            PG8_WAIT_V(8); PG8_WAIT_L(0); PG8_BAR; PG8_MMA(1, 0, At, B0); PG8_MMA(1, 1, At, B1); PG8_BAR; PG8_SCHED;
            PG8_LDB(B0, 1, 0); PG8_LDB(B1, 1, 1); PG8_SCHED; PG8_LDA(At, 1, 0); PG8_STAGE(PG8_SA(0, 1), a2 + hA, voffA);
            PG8_WAIT_V(8); PG8_WAIT_L(0); PG8_BAR; PG8_MMA(0, 0, At, B0); PG8_MMA(0, 1, At, B1); PG8_BAR; PG8_SCHED;
            PG8_LDA(At, 1, 1); PG8_STAGE(PG8_SB(1, 0), b3, voffB); PG8_STAGE(PG8_SB(1, 1), b3 + hB, voffB); PG8_STAGE(PG8_SA(1, 0), a3, voffA);
            PG8_WAIT_V(8); PG8_WAIT_L(0); PG8_BAR; PG8_MMA(1, 0, At, B0); PG8_MMA(1, 1, At, B1); PG8_BAR; PG8_SCHED;
        }
        if constexpr (ALIGN_EPI) { if (wr == 0) PG8_BAR; }
        bool keep = false;
        if constexpr (Epi::CHAIN) keep = E.chain(acc, cur, wr, wc, fr, fq);
        else if constexpr (!Epi::AFTER_DRAIN) E(acc, cur, wr, wc, fr, fq);
        if (!has_next) break;
        if (!keep)
#pragma unroll
        for (int a = 0; a < 2; ++a)
#pragma unroll
            for (int b = 0; b < 2; ++b)
#pragma unroll
                for (int m = 0; m < 4; ++m)
#pragma unroll
                    for (int n = 0; n < 2; ++n) acc[a][b][m][n] = (f32x4){0.f, 0.f, 0.f, 0.f};
        cur = nxt; cA = nA; cB = nB; ++ui;
        if constexpr (ALIGN_EPI) { if (wr == 1) PG8_BAR; }
    }
    PG8_WAIT_V(0);
    if constexpr (!ALIGN_EPI) { if (wr == 0) PG8_BAR; }
    PG8_BAR;
    if constexpr (Epi::AFTER_DRAIN) E.fused(acc, cur, wr, wc, fr, fq, lds, wid, lane);
#undef PG8_SA
#undef PG8_SB
#undef PG8_STAGE
#undef PG8_LDA
#undef PG8_LDB
#undef PG8_MMA
#undef PG8_WAIT_V
#undef PG8_WAIT_L
#undef PG8_BAR
#undef PG8_SCHED
}
}

__device__ __forceinline__ unsigned cvtpk(float lo, float hi) { f32x2 v = {lo, hi}; bf16x2_t b = __builtin_convertvector(v, bf16x2_t); return __builtin_bit_cast(unsigned, b); }
__device__ __forceinline__ float bf_lo(unsigned w) { return __builtin_bit_cast(float, w << 16); }
__device__ __forceinline__ float bf_hi(unsigned w) { return __builtin_bit_cast(float, w & 0xffff0000u); }
__device__ __forceinline__ float sigm(float x) { return __builtin_amdgcn_rcpf(1.f + __expf(-x)); }
__device__ __forceinline__ float silu(float x) { return x * __builtin_amdgcn_rcpf(1.f + __expf(-x)); }
__device__ __forceinline__ float wave_sum(float v) {
#pragma unroll
    for (int o = 1; o < 64; o <<= 1) v += __shfl_xor(v, o);
    return v;
}
__device__ __forceinline__ int crow(int r, int hi) { return (r & 3) + 8 * (r >> 2) + 4 * hi; }


__device__ __forceinline__ float dpp_ror1(float v) { return __builtin_bit_cast(float, __builtin_amdgcn_update_dpp(0, __builtin_bit_cast(int, v), 0x121, 0xf, 0xf, false)); }
__device__ __forceinline__ float dpp_ror2(float v) { return __builtin_bit_cast(float, __builtin_amdgcn_update_dpp(0, __builtin_bit_cast(int, v), 0x122, 0xf, 0xf, false)); }
__device__ __forceinline__ float dpp_shr1(float old, float v) { return __builtin_bit_cast(float, __builtin_amdgcn_update_dpp(__builtin_bit_cast(int, old), __builtin_bit_cast(int, v), 0x111, 0xf, 0xf, false)); }
__device__ __forceinline__ float dpp_shr2(float old, float v) { return __builtin_bit_cast(float, __builtin_amdgcn_update_dpp(__builtin_bit_cast(int, old), __builtin_bit_cast(int, v), 0x112, 0xf, 0xf, false)); }


__device__ __forceinline__ int dpp_x1(int v) { return __builtin_amdgcn_update_dpp(0, v, 0xB1, 0xf, 0xf, false); }
__device__ __forceinline__ int dpp_x2(int v) { return __builtin_amdgcn_update_dpp(0, v, 0x4E, 0xf, 0xf, false); }
__device__ __forceinline__ int dpp_x4(int v, bool lowq) { const int up = __builtin_amdgcn_update_dpp(0, v, 0x12C, 0xf, 0xf, false), dn = __builtin_amdgcn_update_dpp(0, v, 0x124, 0xf, 0xf, false); return lowq ? up : dn; }

__device__ __forceinline__ int map_in(int v) {
    const int pn = v >> 8, j = v & 255;
    if (pn < 16) { const int bj = j >> 7, jj = j & 127, wc = jj >> 5, fq = (jj & 31) >> 3, n = (jj & 7) >> 2, e = jj & 3;
        const int sel = bj * 2 + n; const int off = sel == 0 ? 0 : sel == 1 ? 2048 : sel == 2 ? 1024 : 3072;
        return off + pn * 64 + wc * 16 + fq * 4 + e; }
    if (pn < 20) return 4096 + (pn - 16) * 256 + j;
    if (pn < 26) return 5120 + (pn - 20) * 256 + j;
    if (pn < 30) return 6704 + (pn - 26) * 256 + j;
    if (pn < 38) return 7728 + (j >> 7) * 1024 + (pn - 30) * 128 + (j & 127);
    return j < 48 ? 6656 + j : -1;
}

struct EpiProj {
    static constexpr bool PERM = true, AFTER_DRAIN = false, CHAIN = false;
    unsigned char* ws; const float* conv_w; const float* conv_b;
    __device__ __forceinline__ void operator()(const f32x4 (&acc)[2][2][4][2], const pg8::Unit& u, int wr, int wc, int fr, int fq) const {
        const int pn = u.pn; const int row0 = u.pm * 256 + wr * 64 + fr;
        if (pn < 16) {
            bf16_t* UC = (bf16_t*)(ws + WS_UC); bf16_t* GT = (bf16_t*)(ws + WS_GATE); const int ch = pn * 64 + wc * 16 + fq * 4;
            const f32x4 w0 = *(const f32x4*)(conv_w + ch), w1 = *(const f32x4*)(conv_w + 1024 + ch), w2 = *(const f32x4*)(conv_w + 2048 + ch), cbv = *(const f32x4*)(conv_b + ch);
#pragma unroll
            for (int ai = 0; ai < 2; ++ai) {
                f32x4 up = (f32x4){0.f, 0.f, 0.f, 0.f};
#pragma unroll
                for (int m = 0; m < 4; ++m) { const size_t o = (size_t)(row0 + ai * 128 + m * 16) * 1024 + ch;
                    const f32x4 h4 = acc[ai][0][m][0], c4 = acc[ai][0][m][1], b4 = acc[ai][1][m][0], z4 = acc[ai][1][m][1];
                    const f32x4 u4 = h4 * c4; f32x4 g4, y4;
#pragma unroll
                    for (int e = 0; e < 4; ++e) { g4[e] = b4[e] * silu(z4[e]);
                        const float p1 = dpp_shr1(dpp_ror1(up[e]), u4[e]), p2 = dpp_shr2(dpp_ror2(up[e]), u4[e]);
                        y4[e] = g4[e] * (cbv[e] + w0[e] * p2 + w1[e] * p1 + w2[e] * u4[e]); }
                    const bool head = (m == 0) && (fr < 2);
                    u32x2 gg; gg.x = head ? cvtpk(g4[0], g4[1]) : cvtpk(y4[0], y4[1]); gg.y = head ? cvtpk(g4[2], g4[3]) : cvtpk(y4[2], y4[3]);
                    *(u32x2*)(GT + o) = gg;
                    if (head || (m == 3 && fr >= 14)) { u32x2 uu; uu.x = cvtpk(u4[0], u4[1]); uu.y = cvtpk(u4[2], u4[3]);
                        const int run = u.pm * 4 + ai * 2 + wr, slot = head ? fr : fr - 12; *(u32x2*)(UC + ((size_t)(run * 4 + slot)) * 1024 + ch) = uu; }
                    up = u4; }
            }
        } else if (pn >= 30 && pn < 38) {
            bf16_t* R0 = (bf16_t*)(ws + WS_G0); bf16_t* R1 = (bf16_t*)(ws + WS_G1); const int col0 = (pn - 30) * 128 + wc * 32 + fq * 8;
#pragma unroll
            for (int ai = 0; ai < 2; ++ai)
#pragma unroll
                for (int m = 0; m < 4; ++m) { const size_t o = (size_t)(row0 + ai * 128 + m * 16) * 1024 + col0; float rr[8], s1[8];
#pragma unroll
                    for (int e = 0; e < 8; ++e) { const float x0 = acc[ai][0][m][e >> 2][e & 3], x1 = acc[ai][1][m][e >> 2][e & 3];
                        const float e0 = 1.f + __expf(-x0), e1 = 1.f + __expf(-x1); s1[e] = __builtin_amdgcn_rcpf(e1); rr[e] = e1 * __builtin_amdgcn_rcpf(e0); }
                    u32x4 w0, w1; w0.x = cvtpk(rr[0], rr[1]); w0.y = cvtpk(rr[2], rr[3]); w0.z = cvtpk(rr[4], rr[5]); w0.w = cvtpk(rr[6], rr[7]);
                    w1.x = cvtpk(s1[0], s1[1]); w1.y = cvtpk(s1[2], s1[3]); w1.z = cvtpk(s1[4], s1[5]); w1.w = cvtpk(s1[6], s1[7]);
                    *(u32x4*)(R0 + o) = w0; *(u32x4*)(R1 + o) = w1; }
        } else if (pn < 38) {
            bf16_t* dst; int ld; int mode;
            if (pn < 20) { dst = (bf16_t*)(ws + WS_Q) + (pn - 16) * 256; ld = 1024; mode = 0; }
            else if (pn < 26) { dst = (bf16_t*)(ws + WS_KV + (size_t)(pn - 20) * KVARR); ld = 256; mode = 1; }
            else { dst = (bf16_t*)(ws + WS_ZB) + (pn - 26) * 256; ld = 1024; mode = 2; }
            const int col0 = wc * 32 + fq * 8;
#pragma unroll
            for (int ai = 0; ai < 2; ++ai)
#pragma unroll
                for (int m = 0; m < 4; ++m) { bf16_t* rowp = dst + (size_t)(row0 + ai * 128 + m * 16) * ld + col0;
#pragma unroll
                    for (int bj = 0; bj < 2; ++bj) { f32x4 v0 = acc[ai][bj][m][0], v1 = acc[ai][bj][m][1];
                        if (mode == 0) { v0 = v0 * QSCALE; v1 = v1 * QSCALE; }
                        else if (mode == 2) { for (int e = 0; e < 4; ++e) { v0[e] = silu(v0[e]); v1[e] = silu(v1[e]); } }
                        else if (mode == 3) { for (int e = 0; e < 4; ++e) { v0[e] = sigm(v0[e]); v1[e] = sigm(v1[e]); } }
                        u32x4 w; w.x = cvtpk(v0[0], v0[1]); w.y = cvtpk(v0[2], v0[3]); w.z = cvtpk(v1[0], v1[1]); w.w = cvtpk(v1[2], v1[3]);
                        *(u32x4*)(rowp + bj * 128) = w; } }
        } else {
            float* GN = (float*)(ws + WS_GNSA); const int col0 = wc * 32 + fq * 8;
            if (col0 < 48) {
#pragma unroll
                for (int ai = 0; ai < 2; ++ai)
#pragma unroll
                    for (int m = 0; m < 4; ++m) { float* rp = GN + (size_t)(row0 + ai * 128 + m * 16) * 48 + col0;
                        f32x4 v0 = acc[ai][0][m][0], v1 = acc[ai][0][m][1];
                        for (int e = 0; e < 4; ++e) { v0[e] = sigm(v0[e]); v1[e] = sigm(v1[e]); }
                        *(f32x4*)rp = v0; *(f32x4*)(rp + 4) = v1; }
            }
        }
    }
};
struct EpiCmp {
    static constexpr bool PERM = false, AFTER_DRAIN = false, CHAIN = false;
    float* part;
    __device__ __forceinline__ void operator()(const f32x4 (&acc)[2][2][4][2], const pg8::Unit& u, int wr, int wc, int fr, int fq) const {
        const int b = u.pm >> 1, gp = u.pm & 1;
        float* base = (float*)((unsigned char*)part + (size_t)b * DO_BATCH + DO_PART) + ((size_t)(u.aux * 2 + u.pn) * 512) * 128;
#pragma unroll
        for (int ai = 0; ai < 2; ++ai)
#pragma unroll
            for (int m = 0; m < 4; ++m) { const int c = wr * 64 + m * 16 + fr; const int row = (gp * 2 + ai) * 128 + c;
#pragma unroll
                for (int n = 0; n < 2; ++n) *(f32x4*)(base + (size_t)row * 128 + wc * 32 + n * 16 + fq * 4) = acc[ai][0][m][n]; }
    }
};
struct EpiYa {
    static constexpr bool PERM = true, AFTER_DRAIN = false, CHAIN = false;
    bf16_t* G0;
    __device__ __forceinline__ void operator()(const f32x4 (&acc)[2][2][4][2], const pg8::Unit& u, int wr, int wc, int fr, int fq) const {
        const int row0 = u.pm * 256 + wr * 64 + fr, col0 = u.pn * 256 + wc * 32 + fq * 8;
#pragma unroll
        for (int ai = 0; ai < 2; ++ai)
#pragma unroll
            for (int m = 0; m < 4; ++m)
#pragma unroll
                for (int bj = 0; bj < 2; ++bj) { bf16_t* p = G0 + (size_t)(row0 + ai * 128 + m * 16) * 1024 + col0 + bj * 128;
                    const u32x4 gv = *(const u32x4*)p; const f32x4 v0 = acc[ai][bj][m][0], v1 = acc[ai][bj][m][1]; u32x4 w;
                    w.x = cvtpk(bf_lo(gv.x) * v0[0], bf_hi(gv.x) * v0[1]); w.y = cvtpk(bf_lo(gv.y) * v0[2], bf_hi(gv.y) * v0[3]);
                    w.z = cvtpk(bf_lo(gv.z) * v1[0], bf_hi(gv.z) * v1[1]); w.w = cvtpk(bf_lo(gv.w) * v1[2], bf_hi(gv.w) * v1[3]);
                    *(u32x4*)p = w; }
    }
};
struct EpiMix {
    static constexpr bool PERM = true, AFTER_DRAIN = false, CHAIN = false;
    const bf16_t* G0; bf16_t* G1;
    __device__ __forceinline__ void operator()(const f32x4 (&acc)[2][2][4][2], const pg8::Unit& u, int wr, int wc, int fr, int fq) const {
        const int row0 = u.pm * 256 + wr * 64 + fr, col0 = u.pn * 256 + wc * 32 + fq * 8;
#pragma unroll
        for (int ai = 0; ai < 2; ++ai)
#pragma unroll
            for (int m = 0; m < 4; ++m)
#pragma unroll
                for (int bj = 0; bj < 2; ++bj) { const size_t o = (size_t)(row0 + ai * 128 + m * 16) * 1024 + col0 + bj * 128;
                    const u32x4 gv = *(const u32x4*)(G1 + o); const u32x4 ya = *(const u32x4*)(G0 + o); const f32x4 v0 = acc[ai][bj][m][0], v1 = acc[ai][bj][m][1]; u32x4 w;
                    w.x = cvtpk(bf_lo(gv.x) * v0[0] + bf_lo(ya.x), bf_hi(gv.x) * v0[1] + bf_hi(ya.x)); w.y = cvtpk(bf_lo(gv.y) * v0[2] + bf_lo(ya.y), bf_hi(gv.y) * v0[3] + bf_hi(ya.y));
                    w.z = cvtpk(bf_lo(gv.z) * v1[0] + bf_lo(ya.z), bf_hi(gv.z) * v1[1] + bf_hi(ya.z)); w.w = cvtpk(bf_lo(gv.w) * v1[2] + bf_lo(ya.w), bf_hi(gv.w) * v1[3] + bf_hi(ya.w));
                    *(u32x4*)(G1 + o) = w; }
    }
};

struct EpiPair {
    static constexpr bool PERM = true, AFTER_DRAIN = false, CHAIN = true;
    const bf16_t* G0; bf16_t* G1;
    __device__ __forceinline__ bool chain(f32x4 (&acc)[2][2][4][2], const pg8::Unit& u, int wr, int wc, int fr, int fq) const {
        const int row0 = u.pm * 256 + wr * 64 + fr, col0 = u.pn * 256 + wc * 32 + fq * 8;
        if (u.aux == 0) {
#pragma unroll
            for (int ai = 0; ai < 2; ++ai)
#pragma unroll
                for (int m = 0; m < 4; ++m)
#pragma unroll
                    for (int bj = 0; bj < 2; ++bj) { const size_t o = (size_t)(row0 + ai * 128 + m * 16) * 1024 + col0 + bj * 128;
                        const u32x4 a0 = *(const u32x4*)(G0 + o);
                        const f32x4 r0 = (f32x4){bf_lo(a0.x), bf_hi(a0.x), bf_lo(a0.y), bf_hi(a0.y)}, r1 = (f32x4){bf_lo(a0.z), bf_hi(a0.z), bf_lo(a0.w), bf_hi(a0.w)};
                        acc[ai][bj][m][0] = acc[ai][bj][m][0] * r0; acc[ai][bj][m][1] = acc[ai][bj][m][1] * r1; }
            return true;
        }
#pragma unroll
        for (int ai = 0; ai < 2; ++ai)
#pragma unroll
            for (int m = 0; m < 4; ++m)
#pragma unroll
                for (int bj = 0; bj < 2; ++bj) { const size_t o = (size_t)(row0 + ai * 128 + m * 16) * 1024 + col0 + bj * 128;
                    const u32x4 gv = *(const u32x4*)(G1 + o); const f32x4 v0 = acc[ai][bj][m][0], v1 = acc[ai][bj][m][1]; u32x4 w;
                    w.x = cvtpk(bf_lo(gv.x) * v0[0], bf_hi(gv.x) * v0[1]); w.y = cvtpk(bf_lo(gv.y) * v0[2], bf_hi(gv.y) * v0[3]);
                    w.z = cvtpk(bf_lo(gv.z) * v1[0], bf_hi(gv.z) * v1[1]); w.w = cvtpk(bf_lo(gv.w) * v1[2], bf_hi(gv.w) * v1[3]);
                    *(u32x4*)(G1 + o) = w; }
        return false;
    }
    __device__ __forceinline__ void operator()(const f32x4 (&)[2][2][4][2], const pg8::Unit&, int, int, int, int) const {}
};
struct EpiOut {
    static constexpr bool PERM = true, AFTER_DRAIN = false, CHAIN = false;
    const float* x; float* out;
    __device__ __forceinline__ void operator()(const f32x4 (&acc)[2][2][4][2], const pg8::Unit& u, int wr, int wc, int fr, int fq) const {
        const int row0 = u.pm * 256 + wr * 64 + fr, col0 = u.pn * 256 + wc * 32 + fq * 8;
#pragma unroll
        for (int ai = 0; ai < 2; ++ai)
#pragma unroll
            for (int m = 0; m < 4; ++m)
#pragma unroll
                for (int bj = 0; bj < 2; ++bj) { const size_t o = (size_t)(row0 + ai * 128 + m * 16) * 1024 + col0 + bj * 128;
                    const f32x4 x0 = *(const f32x4*)(x + o), x1 = *(const f32x4*)(x + o + 4);
                    *(f32x4*)(out + o) = x0 + acc[ai][bj][m][0]; *(f32x4*)(out + o + 4) = x1 + acc[ai][bj][m][1]; }
    }
};


struct EpiOutNorm {
    static constexpr bool PERM = true, AFTER_DRAIN = true, CHAIN = false;
    const float* x; float* out; const float* fnw; float* xbuf; unsigned* cnt;
    __device__ __forceinline__ void operator()(const f32x4 (&)[2][2][4][2], const pg8::Unit&, int, int, int, int) const {}
    __device__ __forceinline__ void fused(f32x4 (&acc)[2][2][4][2], const pg8::Unit& u, int wr, int wc, int fr, int fq, LAS unsigned char* lds, int wid, int lane) const {
        const int row0 = u.pm * 256 + wr * 64 + fr, col0 = u.pn * 256 + wc * 32 + fq * 8;
        LAS float* Pp = (LAS float*)lds; LAS float* S = (LAS float*)(lds + 4096);
#pragma unroll
        for (int ai = 0; ai < 2; ++ai)
#pragma unroll
            for (int m = 0; m < 4; ++m) { float ss = 0.f;
#pragma unroll
                for (int bj = 0; bj < 2; ++bj) { const size_t o = (size_t)(row0 + ai * 128 + m * 16) * 1024 + col0 + bj * 128;
                    const f32x4 v0 = *(const f32x4*)(x + o) + acc[ai][bj][m][0], v1 = *(const f32x4*)(x + o + 4) + acc[ai][bj][m][1];
                    acc[ai][bj][m][0] = v0; acc[ai][bj][m][1] = v1;
                    ss += (v0[0] * v0[0] + v0[1] * v0[1]) + (v0[2] * v0[2] + v0[3] * v0[3]) + (v1[0] * v1[0] + v1[1] * v1[1]) + (v1[2] * v1[2] + v1[3] * v1[3]); }
                ss += __shfl_xor(ss, 16); ss += __shfl_xor(ss, 32);
                if (fq == 0) Pp[(ai * 128 + wr * 64 + m * 16 + fr) * 4 + wc] = ss; }
        asm volatile("s_waitcnt lgkmcnt(0)" ::: "memory"); __builtin_amdgcn_s_barrier(); asm volatile("" ::: "memory");
        const int row = wid * 32 + (lane & 31);
        if (lane < 32) { const float t = (Pp[row * 4 + 0] + Pp[row * 4 + 1]) + (Pp[row * 4 + 2] + Pp[row * 4 + 3]);
            __hip_atomic_store(xbuf + (size_t)(u.pm * 256 + row) * 4 + u.pn, t, __ATOMIC_RELAXED, __HIP_MEMORY_SCOPE_AGENT); }
        asm volatile("s_waitcnt vmcnt(0)" ::: "memory");
        if (lane == 0) __hip_atomic_fetch_add(cnt + 64 * u.pm, 1u, __ATOMIC_RELAXED, __HIP_MEMORY_SCOPE_AGENT);
        if (wid == 0) {
            unsigned sp = 0;
            while ((unsigned)__builtin_amdgcn_readfirstlane((int)__hip_atomic_load(cnt + 64 * u.pm, __ATOMIC_RELAXED, __HIP_MEMORY_SCOPE_AGENT)) < 32u) { __builtin_amdgcn_s_sleep(2); if (++sp > (1u << 22)) break; }
            __builtin_amdgcn_fence(__ATOMIC_ACQUIRE, "agent");
        }
        asm volatile("s_waitcnt vmcnt(0) lgkmcnt(0)" ::: "memory"); __builtin_amdgcn_s_barrier(); asm volatile("" ::: "memory");
        if (lane < 32) { const float* slot = xbuf + (size_t)(u.pm * 256 + row) * 4; float t = 0.f;
#pragma unroll
            for (int q = 0; q < 4; ++q) t += __hip_atomic_load(slot + q, __ATOMIC_RELAXED, __HIP_MEMORY_SCOPE_AGENT);
            S[row] = 1.0f / sqrtf(t * (1.f / 1024.f) + NORM_EPS); }
        asm volatile("s_waitcnt lgkmcnt(0)" ::: "memory"); __builtin_amdgcn_s_barrier(); asm volatile("" ::: "memory");
        f32x4 wv[2][2];
#pragma unroll
        for (int bj = 0; bj < 2; ++bj) { wv[bj][0] = *(const f32x4*)(fnw + col0 + bj * 128); wv[bj][1] = *(const f32x4*)(fnw + col0 + bj * 128 + 4); }
#pragma unroll
        for (int ai = 0; ai < 2; ++ai)
#pragma unroll
            for (int m = 0; m < 4; ++m) { const float rs = S[ai * 128 + wr * 64 + m * 16 + fr];
#pragma unroll
                for (int bj = 0; bj < 2; ++bj) { const size_t o = (size_t)(row0 + ai * 128 + m * 16) * 1024 + col0 + bj * 128;
                    *(f32x4*)(out + o) = acc[ai][bj][m][0] * rs * wv[bj][0]; *(f32x4*)(out + o + 4) = acc[ai][bj][m][1] * rs * wv[bj][1]; } }
    }
};

template <class Map>
__device__ __forceinline__ void transpose_item(const float* W, int ldw, int K, int nblk, bf16_t* WT, int row_off, LAS float* scr, int item, int lane, Map map) {
    const int kb = item / nblk, nb = item % nblk, k0 = 64 * kb, n0 = 32 * nb;
    const int src = map(n0 + (lane & 31));
    float tv[32];
    const float* wp = W + (size_t)(k0 + (lane >> 5)) * ldw + (src >= 0 ? src : 0);
#pragma unroll
    for (int i = 0; i < 32; ++i) tv[i] = wp[(size_t)(2 * i) * ldw];
#pragma unroll
    for (int i = 0; i < 32; ++i) { const int kk = 2 * i + (lane >> 5); scr[kk * 33 + (lane & 31)] = src >= 0 ? tv[i] : 0.f; }
    asm volatile("s_waitcnt lgkmcnt(0)" ::: "memory");
    const int c = lane & 7;
#pragma unroll
    for (int j = 0; j < 4; ++j) { const int n = (lane >> 3) + 8 * j; const LAS float* s = scr + (8 * c) * 33 + n;
        u32x4 o; o.x = cvtpk(s[0 * 33], s[1 * 33]); o.y = cvtpk(s[2 * 33], s[3 * 33]); o.z = cvtpk(s[4 * 33], s[5 * 33]); o.w = cvtpk(s[6 * 33], s[7 * 33]);
        *(u32x4*)(WT + (size_t)(row_off + n0 + n) * K + k0 + 8 * c) = o; }
    asm volatile("s_waitcnt lgkmcnt(0)" ::: "memory");
}

template <class RowMap>
__device__ __forceinline__ void transpose_item64(const float* W, int ldw, int ncols, int K, int nblk, bf16_t* WT, LAS float* scr, int item, int lane, RowMap rowmap) {
    const int kb = item / nblk, nb = item % nblk, k0 = 64 * kb, n0 = 64 * nb;
    const int sc = n0 + lane; const bool valid = sc < ncols;
    const float* wp = W + (size_t)k0 * ldw + (valid ? sc : 0);
    float tv[64];
#pragma unroll
    for (int i = 0; i < 64; ++i) tv[i] = wp[(size_t)i * ldw];
#pragma unroll
    for (int i = 0; i < 64; ++i) scr[i * 65 + lane] = tv[i];
    asm volatile("s_waitcnt lgkmcnt(0)" ::: "memory");
    const int c = lane & 7;
#pragma unroll
    for (int j = 0; j < 8; ++j) { const int n = (lane >> 3) + 8 * j, sn = n0 + n; const int row = sn < ncols ? rowmap(sn) : -1; const LAS float* sp = scr + (8 * c) * 65 + n;
        u32x4 o; o.x = cvtpk(sp[0 * 65], sp[1 * 65]); o.y = cvtpk(sp[2 * 65], sp[3 * 65]); o.z = cvtpk(sp[4 * 65], sp[5 * 65]); o.w = cvtpk(sp[6 * 65], sp[7 * 65]);
        if (row >= 0) *(u32x4*)(WT + (size_t)row * K + k0 + 8 * c) = o; }
    asm volatile("s_waitcnt lgkmcnt(0)" ::: "memory");
}
struct RowIn { __device__ __forceinline__ int operator()(int sc) const {
    if (sc < 4096) { const int chunk = sc >> 10, c = sc & 1023; const int bj = chunk & 1, n = chunk >> 1;
        return (c >> 6) * 256 + bj * 128 + ((c >> 4) & 3) * 32 + ((c >> 2) & 3) * 8 + n * 4 + (c & 3); }
    if (sc < 5120) return 16 * 256 + (sc - 4096);
    if (sc < 6656) return 20 * 256 + (sc - 5120);
    if (sc < 6704) return 38 * 256 + (sc - 6656);
    if (sc < 7728) return 26 * 256 + (sc - 6704);
    { const int t = sc - 7728, ch = t & 1023; return (30 + (ch >> 7)) * 256 + (t >> 10) * 128 + (ch & 127); } } };
struct RowOff { int off; __device__ __forceinline__ int operator()(int sc) const { return off + sc; } };
struct MapIn { __device__ __forceinline__ int operator()(int v) const { return map_in(v); } };
struct MapId { __device__ __forceinline__ int operator()(int v) const { return v; } };

constexpr int L_KB = 0, L_VB = 16384, L_KC = 32768, L_VC = 49152, L_IMP = 65536, L_SEL = L_IMP + 4 * 64 * 33 * 4, L_SELU = L_SEL + 256, L_WSF = L_SELU + 256, L_QN = 102400  ;
static_assert(L_WSF + 8 * 64 * 4 <= L_QN && L_QN + 32768 <= LDS_BYTES - 64, "attention LDS map");

__device__ __forceinline__ void qk_tile(f32x16& p0, f32x16& p1, LAS const unsigned char* kt, const bf16x8* qr, int r32, int hi) {
    LAS const unsigned char* kb = kt + hi * 1024 + r32 * 16;
#pragma unroll
    for (int d0 = 0; d0 < 4; ++d0) {
        const bf16x8 b0 = *(LAS const bf16x8*)(kb + d0 * 2048), b1 = *(LAS const bf16x8*)(kb + d0 * 2048 + 512);
        p0 = __builtin_amdgcn_mfma_f32_32x32x16_bf16(b0, qr[d0], p0, 0, 0, 0);
        p1 = __builtin_amdgcn_mfma_f32_32x32x16_bf16(b1, qr[d0], p1, 0, 0, 0);
    }
    __builtin_amdgcn_sched_barrier(0);
}
__device__ __forceinline__ s16x4 vtr(LAS const unsigned char* p) { return __builtin_bit_cast(s16x4, __builtin_amdgcn_ds_read_tr16_b64_v4i16((LAS s16x4*)p)); }
__device__ __forceinline__ void pv_tile(f32x16* o, LAS const unsigned char* vt, int lane, int hi, const f32x16& p0, const f32x16& p1) {
    LAS const unsigned char* vb = vt + ((lane >> 4) & 1) * 32 + (lane & 3) * 8 + (4 * hi + ((lane & 15) >> 2)) * 64;
    u32x4 pw[4];
    pw[0] = (u32x4){cvtpk(p0[0], p0[1]), cvtpk(p0[2], p0[3]), cvtpk(p0[4], p0[5]), cvtpk(p0[6], p0[7])};
    pw[1] = (u32x4){cvtpk(p0[8], p0[9]), cvtpk(p0[10], p0[11]), cvtpk(p0[12], p0[13]), cvtpk(p0[14], p0[15])};
    pw[2] = (u32x4){cvtpk(p1[0], p1[1]), cvtpk(p1[2], p1[3]), cvtpk(p1[4], p1[5]), cvtpk(p1[6], p1[7])};
    pw[3] = (u32x4){cvtpk(p1[8], p1[9]), cvtpk(p1[10], p1[11]), cvtpk(p1[12], p1[13]), cvtpk(p1[14], p1[15])};
    __builtin_amdgcn_sched_barrier(0);
#pragma unroll
    for (int d0 = 0; d0 < 2; ++d0)
#pragma unroll
        for (int ks = 0; ks < 4; ++ks) {
            const s16x4 lo = vtr(vb + d0 * 4096 + ks * 1024), hh = vtr(vb + d0 * 4096 + ks * 1024 + 512);
            const bf16x8 vf = (bf16x8){lo[0], lo[1], lo[2], lo[3], hh[0], hh[1], hh[2], hh[3]};
            o[d0] = __builtin_amdgcn_mfma_f32_32x32x16_bf16(__builtin_bit_cast(bf16x8, pw[ks]), vf, o[d0], 0, 0, 0);
            if (ks == 3) __builtin_amdgcn_sched_barrier(0);
        }
}

struct AttnP { const bf16_t* Q; const unsigned char* KV; const bf16_t* KC; const bf16_t* VC; const float* GN; bf16_t* ZB; };

template <int MODE>
__device__ __forceinline__ void attn_branch(const AttnP& P, LAS unsigned char* lds, int b, int g, int i, unsigned tilemask, unsigned selmask,
                                            const bf16x8* qr, float slope2, int a, f32x16* oacc, float gate, LAS float* wsf, u32x4 kreg, u32x4 vreg) {
    const int tid = threadIdx.x, lane = tid & 63, r32 = lane & 31, hi = lane >> 5; const int wid = __builtin_amdgcn_readfirstlane(tid >> 6);
    const bf16_t* Kg = (const bf16_t*)(P.KV + (size_t)(MODE == 1 ? 2 : 4) * KVARR) + (size_t)b * T * 256 + g * 64;
    const bf16_t* Vg = (const bf16_t*)((const unsigned char*)Kg + KVARR);
    const bf16_t* ksrc = Kg + (size_t)lane * 256 + wid * 8;
    const bf16_t* vsrc = Vg + (size_t)(16 * (wid & 3) + (lane >> 2)) * 256 + (wid >> 2) * 32 + (lane & 3) * 8;
    const int stoff = wid * 1024 + lane * 16;
    const unsigned himask = hi ? 0u : 0xffffffffu;
    const float s_hi = bf_lo(cvtpk(slope2, 0.f) & 0xffffu) , s_lo = slope2 - s_hi;
    u32x4 qx; qx.x = cvtpk(s_hi, s_lo) & himask; qx.y = qx.x; qx.z = 0u; qx.w = 0u;
    u32x4 kx0, kx1; kx0.x = cvtpk((float)r32, (float)r32) & himask; kx1.x = cvtpk((float)(r32 + 32), (float)(r32 + 32)) & himask;
    kx0.z = 0x3f803f80u & himask; kx1.z = kx0.z; kx0.w = 0u; kx1.w = 0u;
    f32x16 o[2]; o[0] = f32x16{}; o[1] = f32x16{};
    float m_run = 0.f, l_run = 0.f; unsigned negm_bits = 0u; bool first = true;
    unsigned rem = (unsigned)__builtin_amdgcn_readfirstlane((int)tilemask);
    int j = 31 - __builtin_clz(rem); rem &= ~(1u << j);
    int buf = 0;
    for (;;) {
        *(LAS u32x4*)(lds + L_KB + buf * 8192 + stoff) = kreg; *(LAS u32x4*)(lds + L_VB + buf * 8192 + stoff) = vreg;
        __syncthreads();
        int jn = -1;
        if (rem) { jn = 31 - __builtin_clz(rem); rem &= ~(1u << jn); kreg = *(const u32x4*)(ksrc + (size_t)jn * 64 * 256); vreg = *(const u32x4*)(vsrc + (size_t)jn * 64 * 256); }
        { const float tb = (float)(64 * (j - i)); kx0.y = cvtpk(tb, tb) & himask; kx1.y = kx0.y; }
        f32x16 p0, p1; float ls = 0.f; bool need = first;
#pragma unroll 1
        for (int pass = 0; pass < 2; ++pass) {
            qx.z = negm_bits | ((MODE == 1 && !((selmask >> j) & 1u)) ? (0x0000f14au & himask) : 0u);
            p0 = __builtin_amdgcn_mfma_f32_32x32x16_bf16(__builtin_bit_cast(bf16x8, kx0), __builtin_bit_cast(bf16x8, qx), f32x16{}, 0, 0, 0);
            p1 = __builtin_amdgcn_mfma_f32_32x32x16_bf16(__builtin_bit_cast(bf16x8, kx1), __builtin_bit_cast(bf16x8, qx), f32x16{}, 0, 0, 0);
            qk_tile(p0, p1, lds + L_KB + buf * 8192, qr, r32, hi);
            if (j == i || (MODE == 2 && j == i - 8)) {
                int lo2 = (j == i ? 0 : a + 1) - 4 * hi, hb2 = (j == i ? a : 63) - 4 * hi; asm volatile("" : "+v"(lo2), "+v"(hb2));
#pragma unroll
                for (int r = 0; r < 16; ++r) { const int cr = (r & 3) + 8 * (r >> 2); if (cr < lo2 || cr > hb2) p0[r] = -1e30f; if (cr + 32 < lo2 || cr + 32 > hb2) p1[r] = -1e30f; }
            }
            if (need) {
                float mx = fmaxf(fmaxf(p0[0], p0[1]), p0[2]);
#pragma unroll
                for (int r = 3; r < 15; r += 2) mx = fmaxf(fmaxf(mx, p0[r]), p0[r + 1]);
                mx = fmaxf(fmaxf(mx, p0[15]), p1[0]);
#pragma unroll
                for (int r = 1; r < 15; r += 2) mx = fmaxf(fmaxf(mx, p1[r]), p1[r + 1]);
                mx = fmaxf(mx, p1[15]);
                mx = fmaxf(mx, __shfl_xor(mx, 32));
                if (first || __any(mx > 8.f)) {
                    const float dd = first ? (mx > -1e29f ? mx : 0.f) : fmaxf(mx, 0.f);
                    const unsigned mb = cvtpk(m_run + dd, 0.f) & 0xffffu; const float m_new = bf_lo(mb); const float delta = m_new - m_run;
#pragma unroll
                    for (int r = 0; r < 16; ++r) { p0[r] -= delta; p1[r] -= delta; }
                    if (!first) { const float f = __builtin_amdgcn_exp2f(-delta); l_run *= f;
                        if (hi == 0) wsf[r32] = f;
                        asm volatile("" ::: "memory");
#pragma unroll
                        for (int r = 0; r < 16; ++r) { const float fr_ = wsf[crow(r, hi)]; o[0][r] *= fr_; o[1][r] *= fr_; } }
                    m_run = m_new; negm_bits = (m_new == 0.f) ? 0u : (((mb ^ 0x8000u) << 16) & himask); first = false;
                }
            }
            ls = 0.f;
#pragma unroll
            for (int r = 0; r < 16; ++r) { p0[r] = __builtin_amdgcn_exp2f(p0[r]); p1[r] = __builtin_amdgcn_exp2f(p1[r]); ls += p0[r] + p1[r]; }
            if (need || !__any(!(ls <= 256.f))) break;
            need = true;
        }
        l_run += ls;
        if (__any(ls > 0.f)) pv_tile(o, lds + L_VB + buf * 8192, lane, hi, p0, p1);
        if (jn < 0) break;
        j = jn; buf ^= 1;
    }
    const float lt = l_run + __shfl_xor(l_run, 32);
    const float coef = lt > 0.f ? gate / lt : 0.f;
    asm volatile("" ::: "memory");
    if (hi == 0) wsf[32 + r32] = coef;
    asm volatile("" ::: "memory");
#pragma unroll
    for (int r = 0; r < 16; ++r) { const float cf = wsf[32 + crow(r, hi)]; oacc[0][r] += o[0][r] * cf; oacc[1][r] += o[1][r] * cf; }
    asm volatile("" : "+v"(oacc[0]), "+v"(oacc[1]));
    __syncthreads();
}


template <int MODE>
__device__ __forceinline__ void attn_first_tile(const AttnP& P, int b, int g, int i, u32x4& kreg, u32x4& vreg) {
    const int tid = threadIdx.x, lane = tid & 63; const int wid = __builtin_amdgcn_readfirstlane(tid >> 6);
    const bf16_t* Kg = (const bf16_t*)(P.KV + (size_t)(MODE == 1 ? 2 : 4) * KVARR) + (size_t)b * T * 256 + g * 64;
    const bf16_t* Vg = (const bf16_t*)((const unsigned char*)Kg + KVARR);
    kreg = *(const u32x4*)(Kg + (size_t)(64 * i + lane) * 256 + wid * 8);
    vreg = *(const u32x4*)(Vg + (size_t)(64 * i + 16 * (wid & 3) + (lane >> 2)) * 256 + (wid >> 2) * 32 + (lane & 3) * 8);
}


__device__ __forceinline__ void glds16(const void* gsrc, unsigned lds_dst) { unsigned keep;
    asm volatile("s_mov_b32 %0, m0\n\ts_mov_b32 m0, %2\n\ts_nop 0\n\tglobal_load_lds_dwordx4 %1, off\n\ts_mov_b32 m0, %0" : "=&s"(keep) : "v"(gsrc), "s"(lds_dst) : "memory"); }
__device__ __forceinline__ void attn_prefetch(const AttnP& P, LAS unsigned char* lds, int b, int g, int i) {
    const int tid = threadIdx.x, lane = tid & 63; const int wid = __builtin_amdgcn_readfirstlane(tid >> 6);
    const int hr = wid >> 1, qh = wid & 1, h = 4 * g + hr;
    const unsigned l0 = (unsigned)(size_t)lds;
    const bf16_t* qsrc = P.Q + ((size_t)b * T + 64 * i + 32 * qh + (lane >> 3)) * 1024 + h * 64 + (lane & 7) * 8;
#pragma unroll
    for (int k = 0; k < 4; ++k) glds16(qsrc + (size_t)k * 8 * 1024, (unsigned)__builtin_amdgcn_readfirstlane((int)(l0 + L_QN + wid * 4096 + k * 1024)));
    const bf16_t* kcb = P.KC + (size_t)(b * 4 + g) * 128 * 64; const bf16_t* vcb = P.VC + (size_t)(b * 4 + g) * 128 * 64;
#pragma unroll
    for (int tt = 0; tt < 2; ++tt) {
        glds16(kcb + (size_t)(tt * 64 + lane) * 64 + wid * 8, (unsigned)__builtin_amdgcn_readfirstlane((int)(l0 + L_KC + tt * 8192 + wid * 1024)));
        glds16(vcb + (size_t)(tt * 64 + 16 * (wid & 3) + (lane >> 2)) * 64 + (wid >> 2) * 32 + (lane & 3) * 8, (unsigned)__builtin_amdgcn_readfirstlane((int)(l0 + L_VC + tt * 8192 + wid * 1024)));
    }
}

__device__ __forceinline__ void attn_unit(const AttnP& P, LAS unsigned char* lds, int b, int g, int i, bool has_next, int nb, int ng, int ni) {
    const int tid = threadIdx.x, lane = tid & 63, r32 = lane & 31, hi = lane >> 5; const int wid = __builtin_amdgcn_readfirstlane(tid >> 6);
    const int hr = wid >> 1, qh = wid & 1, h = 4 * g + hr, a = 32 * qh + r32, t = 64 * i + a;
    const size_t rowq = (size_t)b * T + t;
    const float slope2 = exp2f(-0.5f * (float)(h + 1)) * LOG2E;
    asm volatile("s_waitcnt vmcnt(0)" ::: "memory");
    if (tid == 0) *(LAS unsigned*)(lds + L_SELU) = 0u;
    __syncthreads();
    bf16x8 qr[4];
#pragma unroll
    for (int d0 = 0; d0 < 4; ++d0) qr[d0] = *(const LAS bf16x8*)(lds + L_QN + wid * 4096 + r32 * 128 + d0 * 32 + hi * 16);
    const float g_cmp = P.GN[rowq * 48 + h * 3 + 0], g_slc = P.GN[rowq * 48 + h * 3 + 1], g_win = P.GN[rowq * 48 + h * 3 + 2];
    LAS float* wsf = (LAS float*)(lds + L_WSF) + wid * 64;
    u32x4 k1, v1; attn_first_tile<1>(P, b, g, i, k1, v1);
    f32x16 oacc[2]; oacc[0] = f32x16{}; oacc[1] = f32x16{};
    {
        f32x16 p[4];
#pragma unroll
        for (int ct = 0; ct < 4; ++ct) p[ct] = f32x16{};
        qk_tile(p[0], p[1], lds + L_KC, qr, r32, hi);
        const bool two = (4 * i + 3) > 64;
        if (two) qk_tile(p[2], p[3], lds + L_KC + 8192, qr, r32, hi);
        float mx = -1e30f;
#pragma unroll
        for (int ct = 0; ct < 4; ++ct)
#pragma unroll
            for (int r = 0; r < 16; ++r) { const int c = 32 * ct + crow(r, hi); const int dist = t - 31 - 16 * c;
                const float s = dist >= 0 ? p[ct][r] - slope2 * (float)dist : -1e30f; p[ct][r] = s; mx = fmaxf(mx, s); }
        mx = fmaxf(mx, __shfl_xor(mx, 32));
        float ls = 0.f;
#pragma unroll
        for (int ct = 0; ct < 4; ++ct)
#pragma unroll
            for (int r = 0; r < 16; ++r) { const float e = p[ct][r] > -1e29f ? __builtin_amdgcn_exp2f(p[ct][r] - mx) : 0.f; p[ct][r] = e; ls += e; }
        ls += __shfl_xor(ls, 32);
        const float inv = ls > 0.f ? 1.f / ls : 0.f;
#pragma unroll
        for (int ct = 0; ct < 4; ++ct)
#pragma unroll
            for (int r = 0; r < 16; ++r) p[ct][r] *= inv;
        LAS float* imph = (LAS float*)(lds + L_IMP) + (hr * 64 + a) * 33;
#pragma unroll
        for (int ct = 0; ct < 4; ++ct)
#pragma unroll
            for (int g4 = 0; g4 < 4; ++g4) { const int jj = 8 * ct + 2 * g4 + hi; imph[jj] = (p[ct][4 * g4] + p[ct][4 * g4 + 1]) + (p[ct][4 * g4 + 2] + p[ct][4 * g4 + 3]); }
        asm volatile("s_waitcnt lgkmcnt(0)" ::: "memory");
#pragma unroll
        for (int ct = 0; ct < 4; ++ct)
#pragma unroll
            for (int g4 = 0; g4 < 4; ++g4) { const int jj = 8 * ct + 2 * g4 + hi; imph[jj + 1] += p[ct][4 * g4 + 3]; asm volatile("" ::: "memory"); }
        f32x16 o[2]; o[0] = f32x16{}; o[1] = f32x16{};
        pv_tile(o, lds + L_VC, lane, hi, p[0], p[1]);
        if (two) pv_tile(o, lds + L_VC + 8192, lane, hi, p[2], p[3]);
        if (hi == 0) wsf[32 + r32] = g_cmp;
        asm volatile("" ::: "memory");
#pragma unroll
        for (int r = 0; r < 16; ++r) { const float cf = wsf[32 + crow(r, hi)]; oacc[0][r] += o[0][r] * cf; oacc[1][r] += o[1][r] * cf; }
        asm volatile("" : "+v"(oacc[0]), "+v"(oacc[1]));
    }
    __syncthreads();
    {
        const int qa = tid >> 3, sub = tid & 7;
        unsigned sel;
        if (i <= 7) sel = (2u << i) - 1u;
        else {
            const LAS float* I0 = (const LAS float*)(lds + L_IMP) + qa * 33 + 4 * sub;
            float v[4];
#pragma unroll
            for (int k = 0; k < 4; ++k) { const int jj = 4 * sub + k; const float sum = ((I0[k] + I0[k + 64 * 33]) + I0[k + 2 * 64 * 33]) + I0[k + 3 * 64 * 33]; v[k] = (jj >= 1 && jj <= i - 2) ? sum : -2.f; }
            sel = 1u | (1u << i) | (1u << (i - 1));
            for (int k5 = 0; k5 < 5; ++k5) {
                float bv = -1.f; int bj = 64;
#pragma unroll
                for (int k = 0; k < 4; ++k) if (v[k] > bv) { bv = v[k]; bj = 4 * sub + k; }
#pragma unroll
                for (int off = 1; off < 8; off <<= 1) {
                    const int bvi = __builtin_bit_cast(int, bv); const bool lowq = (tid & 4) == 0;
                    const float pv_ = __builtin_bit_cast(float, off == 1 ? dpp_x1(bvi) : off == 2 ? dpp_x2(bvi) : dpp_x4(bvi, lowq));
                    const int pj = off == 1 ? dpp_x1(bj) : off == 2 ? dpp_x2(bj) : dpp_x4(bj, lowq);
                    if (pv_ > bv || (pv_ == bv && pj < bj)) { bv = pv_; bj = pj; } }
                sel |= 1u << (bj & 31);
#pragma unroll
                for (int k = 0; k < 4; ++k) if (bj == 4 * sub + k) v[k] = -2.f;
            }
        }
        if (sub == 0) { ((LAS unsigned*)(lds + L_SEL))[qa] = sel; if ((tid & 63) == 0) {   } }
        unsigned un = sel;
#pragma unroll
        for (int off = 8; off < 64; off <<= 1) un |= __shfl_xor(un, off);
        if ((tid & 63) == 0) atomicOr((unsigned*)(LAS unsigned*)(lds + L_SELU), un);
    }
    __syncthreads();
    const unsigned selmask = ((LAS unsigned*)(lds + L_SEL))[a];
    const unsigned uni = *(LAS unsigned*)(lds + L_SELU);
    u32x4 k2, v2; attn_first_tile<2>(P, b, g, i, k2, v2);
    attn_branch<1>(P, lds, b, g, i, uni, selmask, qr, slope2, a, oacc, g_slc, wsf, k1, v1);
    if (has_next) attn_prefetch(P, lds, nb, ng, ni);
    const unsigned wmask = (i >= 8) ? (0x1ffu << (i - 8)) : ((2u << i) - 1u);
    attn_branch<2>(P, lds, b, g, i, wmask, 0u, qr, slope2, a, oacc, g_win, wsf, k2, v2);
    {
        LAS float* stg = (LAS float*)(lds + (wid < 4 ? L_KB + wid * 8192 : L_IMP + (wid - 4) * 8192));
#pragma unroll
        for (int r = 0; r < 16; ++r) { const int orow = crow(r, hi);
#pragma unroll
            for (int d0 = 0; d0 < 2; ++d0) stg[orow * 64 + d0 * 32 + r32] = oacc[d0][r]; }
        asm volatile("s_waitcnt lgkmcnt(0)" ::: "memory");
        bf16_t* zb = P.ZB + ((size_t)b * T + 64 * i + 32 * qh) * 1024 + h * 64;
#pragma unroll
        for (int q4 = 0; q4 < 4; ++q4) { const int row = q4 * 8 + (lane >> 3), ch = lane & 7;
            const f32x4 o0 = *(const LAS f32x4*)(stg + row * 64 + ch * 8), o1 = *(const LAS f32x4*)(stg + row * 64 + ch * 8 + 4);
            bf16_t* zp = zb + (size_t)row * 1024 + ch * 8; const u32x4 zv = *(const u32x4*)zp; u32x4 w;
            w.x = cvtpk(o0[0] * bf_lo(zv.x), o0[1] * bf_hi(zv.x)); w.y = cvtpk(o0[2] * bf_lo(zv.y), o0[3] * bf_hi(zv.y));
            w.z = cvtpk(o1[0] * bf_lo(zv.z), o1[1] * bf_hi(zv.z)); w.w = cvtpk(o1[2] * bf_lo(zv.w), o1[3] * bf_hi(zv.w));
            *(u32x4*)zp = w; }
    }
}

#define XB_TMO      128
#define XB_XCNT(j)  (256  + 64 * (j))
#define XB_XSUB(j)  (1280 + 64 * (j))
#define XB_XGEN(j)  (2304 + 64 * (j))
#define XB_TOP      3328
#define XB_TOPGEN   3392
#define XCD_BAR_WORDS 3456
#define XB_SPIN_CAP (1u << 18)
__device__ __forceinline__ unsigned xb_ld(unsigned* p)              { return __hip_atomic_load(p, __ATOMIC_RELAXED, __HIP_MEMORY_SCOPE_AGENT); }
__device__ __forceinline__ unsigned xb_add(unsigned* p, unsigned v) { return __hip_atomic_fetch_add(p, v, __ATOMIC_RELAXED, __HIP_MEMORY_SCOPE_AGENT); }
__device__ __forceinline__ unsigned xb_xcc_id() { return (unsigned)__builtin_amdgcn_s_getreg((3 << 11) | 20) & 0xFu; }
#define XB_SPIN(cond, bar) do { unsigned _sp = 0; while (cond) { __builtin_amdgcn_s_sleep(1); \
    if ((++_sp & 255u) == 0u) { if (xb_ld(&(bar)[XB_TMO])) break; if (_sp > XB_SPIN_CAP) { atomicAdd(&(bar)[XB_TMO], 1u); break; } } } } while (0)
struct XcdBarrier { unsigned* bar; unsigned x; volatile LAS unsigned* st; };
__device__ __forceinline__ XcdBarrier xcd_barrier_post(unsigned* bar, volatile LAS unsigned* st) {
    XcdBarrier b; b.bar = bar; b.x = xb_xcc_id(); b.st = st;
    if (threadIdx.x == 0) (void)xb_add(&bar[XB_XCNT(b.x)], 1u);
    return b;
}
__device__ __forceinline__ void xcd_barrier_complete(unsigned* bar, unsigned x, unsigned& nloc, unsigned& nx) {
    const unsigned G = gridDim.x * gridDim.y * gridDim.z;
    unsigned sum, cnt, mine, sp = 0u;
    for (;;) {
        sum = 0u; cnt = 0u; mine = 0u;
#pragma unroll
        for (unsigned j = 0; j < 16; ++j) { const unsigned c = xb_ld(&bar[XB_XCNT(j)]); sum += c; cnt += (c > 0u) ? 1u : 0u; mine = (j == x) ? c : mine; }
        if (sum == G) break;
        __builtin_amdgcn_s_sleep(1);
        if ((++sp & 255u) == 0u) { if (xb_ld(&bar[XB_TMO])) break; if (sp > XB_SPIN_CAP) { atomicAdd(&bar[XB_TMO], 1u); break; } }
    }
    nloc = mine > 0u ? mine : 1u; nx = cnt > 0u ? cnt : 1u;
}
__device__ __forceinline__ void xcd_barrier(const XcdBarrier& b) {
    asm volatile("s_waitcnt vmcnt(0)" ::: "memory");
    __syncthreads();
    if (threadIdx.x == 0) {
        unsigned* bar = b.bar;
        __builtin_amdgcn_s_waitcnt(0);
        unsigned nloc = b.st[0], nx = b.st[1];
        if (nloc == 0u) { xcd_barrier_complete(bar, b.x, nloc, nx); b.st[0] = nloc; b.st[1] = nx; }
        const unsigned old = xb_add(&bar[XB_XSUB(b.x)], 1u);
        const unsigned gen = old / nloc;
        if (old + 1u == (gen + 1u) * nloc) {
            __builtin_amdgcn_fence(__ATOMIC_RELEASE, "agent");
            asm volatile("s_waitcnt vmcnt(0)" ::: "memory");
            const unsigned og = xb_add(&bar[XB_TOP], 1u);
            const unsigned tg = og / nx;
            if (og + 1u == (tg + 1u) * nx) xb_add(&bar[XB_TOPGEN], 1u);
            else XB_SPIN(xb_ld(&bar[XB_TOPGEN]) == tg, bar);
            __builtin_amdgcn_fence(__ATOMIC_ACQUIRE, "agent");
            xb_add(&bar[XB_XGEN(b.x)], 1u);
            asm volatile("s_waitcnt vmcnt(0)" ::: "memory");
        } else {
            XB_SPIN(xb_ld(&bar[XB_XGEN(b.x)]) == gen, bar);
            __builtin_amdgcn_fence(__ATOMIC_ACQUIRE, "agent");
            asm volatile("s_waitcnt vmcnt(0)" ::: "memory");
        }
    }
    __syncthreads();
}


struct GrpBar { unsigned* sub; unsigned* gen; unsigned n; bool local; };
__device__ __forceinline__ void grp_barrier(const GrpBar& gb) {
    asm volatile("s_waitcnt vmcnt(0)" ::: "memory");
    __syncthreads();
    if (threadIdx.x == 0) {
        __builtin_amdgcn_s_waitcnt(0);
        if (!gb.local) { __builtin_amdgcn_fence(__ATOMIC_RELEASE, "agent"); asm volatile("s_waitcnt vmcnt(0)" ::: "memory"); }
        const unsigned old = xb_add(gb.sub, 1u); const unsigned gen = old / gb.n;
        if (old + 1u == (gen + 1u) * gb.n) xb_add(gb.gen, 1u);
        else { unsigned sp = 0; while (xb_ld(gb.gen) == gen) { __builtin_amdgcn_s_sleep(1); if (++sp > (1u << 24)) break; } }
        __builtin_amdgcn_fence(__ATOMIC_ACQUIRE, "agent");
        asm volatile("s_waitcnt vmcnt(0)" ::: "memory");
    }
    __syncthreads();
}

struct Args { const float* in[15]; float* out; unsigned char* ws; };

__global__ void __launch_bounds__(512, 2) fwd_kernel(Args args) {
    extern __shared__ __attribute__((aligned(16))) unsigned char lds_raw[];
    LAS unsigned char* lds = (LAS unsigned char*)lds_raw;
    cg::grid_group grid = cg::this_grid();
    const int tid = threadIdx.x, lane = tid & 63, wave = __builtin_amdgcn_readfirstlane(tid >> 6);
    const int G = gridDim.x, bx = blockIdx.x; const int vcu = (G % 8 == 0) ? (bx % 8) * (G / 8) + bx / 8 : bx;
    const int gw = vcu * 8 + wave, NGW = G * 8;
    unsigned char* ws = args.ws; unsigned char* dout = (unsigned char*)args.out;
    const float* x = args.in[0]; const float* norm_w = args.in[1]; const float* w_in = args.in[2]; const float* conv_w = args.in[3]; const float* conv_b = args.in[4];
    const float* pe_k = args.in[5]; const float* pe_v = args.in[6]; const float* w1_k = args.in[7]; const float* w2_k = args.in[8]; const float* w1_v = args.in[9]; const float* w2_v = args.in[10];
    const float* w_pa = args.in[11]; const float* w_pb = args.in[12]; const float* w_o = args.in[13]; const float* fnw = args.in[14];
    bf16_t* WINT = (bf16_t*)(ws + WS_WINT);
    volatile LAS unsigned* xst = (volatile LAS unsigned*)(lds + LDS_BYTES - 64);
    if (tid < 2) xst[tid] = 0u;
    __syncthreads();
    XcdBarrier xbar = xcd_barrier_post((unsigned*)ws, xst);
    if (ws == nullptr) grid.sync();
#define GRID_BAR() xcd_barrier(xbar)
    if (tid == 0) __hip_atomic_store((unsigned*)ws + 9216 + bx, xb_xcc_id() + 1u, __ATOMIC_RELAXED, __HIP_MEMORY_SCOPE_AGENT);
    GrpBar gbar; gbar.sub = (unsigned*)ws + 8192 + 64 * (bx & 7); gbar.gen = (unsigned*)ws + 8704 + 64 * (bx & 7); gbar.n = (unsigned)(G / 8); gbar.local = false;
    const bool use_grp = (G == 256);
#define GROUP_BAR() do { if (use_grp) grp_barrier(gbar); else xcd_barrier(xbar); } while (0)

    {
        LAS float* scr = (LAS float*)(lds + wave * 16640);
        constexpr int NB_IN = (NIN + 63) / 64, I_IN = 16 * NB_IN, I_SQ = 16 * 16, I_W1 = 32 * 2;
        constexpr int NITEMS = I_IN + 3 * I_SQ + 3 * I_W1;
        for (int it = gw; it < NITEMS; it += NGW) {
            int r = it;
            if (r < I_IN) { transpose_item64(w_in, NIN, NIN, 1024, NB_IN, WINT, scr, r, lane, RowIn{}); continue; } r -= I_IN;
            if (r < I_SQ) { transpose_item64(w_pa, 1024, 1024, 1024, 16, (bf16_t*)(ws + WS_WA), scr, r, lane, RowOff{0}); continue; } r -= I_SQ;
            if (r < I_SQ) { transpose_item64(w_pb, 1024, 1024, 1024, 16, (bf16_t*)(ws + WS_WB), scr, r, lane, RowOff{0}); continue; } r -= I_SQ;
            if (r < I_SQ) { transpose_item64(w_o, 1024, 1024, 1024, 16, (bf16_t*)(ws + WS_WO), scr, r, lane, RowOff{0}); continue; } r -= I_SQ;
            if (r < I_W1) { transpose_item64(w1_k, 128, 128, 2048, 2, (bf16_t*)(ws + WS_W1S), scr, r, lane, RowOff{0}); continue; } r -= I_W1;
            if (r < I_W1) { transpose_item64(w1_v, 128, 128, 2048, 2, (bf16_t*)(ws + WS_W1S), scr, r, lane, RowOff{128}); continue; } r -= I_W1;
            transpose_item64(w1_k, 128, 128, 2048, 2, (bf16_t*)(ws + WS_W1S), scr, r, lane, RowOff{256});
        }
        for (int q = bx * 512 + tid; q < 208 * 128; q += G * 512) *(u32x4*)(WINT + (size_t)(38 * 256 + 48 + (q >> 7)) * 1024 + (q & 127) * 8) = (u32x4){0u, 0u, 0u, 0u};
        if (gw < 256) {
            const int kvs = gw >> 7, hid = gw & 127; const float* pe = kvs ? pe_v : pe_k; const float* w1 = kvs ? w1_v : w1_k; float s = 0.f;
            for (int kk = lane; kk < 2048; kk += 64) s += pe[kk] * w1[(size_t)kk * 128 + hid];
            s = wave_sum(s);
            if (lane == 0) ((float*)(ws + WS_PEB))[gw] = s;
        }
    }
    unsigned* arrw = (unsigned*)ws + 12288;
    asm volatile("s_waitcnt vmcnt(0)" ::: "memory");
    __syncthreads();
    if (tid == 0) { __builtin_amdgcn_fence(__ATOMIC_RELEASE, "agent"); asm volatile("s_waitcnt vmcnt(0)" ::: "memory"); __hip_atomic_fetch_add(arrw, 1u, __ATOMIC_RELAXED, __HIP_MEMORY_SCOPE_AGENT); }
    {
        const int nrow = use_grp ? 8 : (M + NGW - 1) / NGW;
        for (int k2 = 0; k2 < nrow; k2 += 2) {
            int m, m2;
            if (use_grp) { m = (bx & 7) * T + (bx >> 3) * 64 + wave * 8 + k2; m2 = m + 1; }
            else { m = gw + k2 * NGW; m2 = m + NGW; if (m >= M) break; if (m2 >= M) m2 = m; }
            const f32x4* xr = (const f32x4*)(x + (size_t)m * D) + lane; const f32x4* xr2 = (const f32x4*)(x + (size_t)m2 * D) + lane; f32x4 v[4], v2[4]; float s = 0.f, s2 = 0.f;
#pragma unroll
            for (int j = 0; j < 4; ++j) { v[j] = xr[64 * j]; v2[j] = xr2[64 * j]; }
#pragma unroll
            for (int j = 0; j < 4; ++j) { s += (v[j].x * v[j].x + v[j].y * v[j].y) + (v[j].z * v[j].z + v[j].w * v[j].w); s2 += (v2[j].x * v2[j].x + v2[j].y * v2[j].y) + (v2[j].z * v2[j].z + v2[j].w * v2[j].w); }
#pragma unroll
            for (int o = 1; o < 64; o <<= 1) { s += __shfl_xor(s, o); s2 += __shfl_xor(s2, o); }
            const float rs = 1.0f / sqrtf(s * (1.f / D) + NORM_EPS), rs2 = 1.0f / sqrtf(s2 * (1.f / D) + NORM_EPS);
            u32x2* o8 = (u32x2*)(dout + (size_t)(m >> 11) * DO_BATCH + (size_t)(m & 2047) * 2048) + lane; u32x2* o82 = (u32x2*)(dout + (size_t)(m2 >> 11) * DO_BATCH + (size_t)(m2 & 2047) * 2048) + lane;
#pragma unroll
            for (int j = 0; j < 4; ++j) { const f32x4 w = ((const f32x4*)norm_w)[lane + 64 * j]; u32x2 o; o.x = cvtpk(v[j].x * rs * w.x, v[j].y * rs * w.y); o.y = cvtpk(v[j].z * rs * w.z, v[j].w * rs * w.w); o8[64 * j] = o;
                u32x2 o2; o2.x = cvtpk(v2[j].x * rs2 * w.x, v2[j].y * rs2 * w.y); o2.y = cvtpk(v2[j].z * rs2 * w.z, v2[j].w * rs2 * w.w); o82[64 * j] = o2; }
        }
    }
    if (tid == 0) { unsigned sp = 0; while (__hip_atomic_load(arrw, __ATOMIC_RELAXED, __HIP_MEMORY_SCOPE_AGENT) < (unsigned)G) { __builtin_amdgcn_s_sleep(2); if (++sp > (1u << 24)) break; }
        __builtin_amdgcn_fence(__ATOMIC_ACQUIRE, "agent"); asm volatile("s_waitcnt vmcnt(0)" ::: "memory"); }
    __syncthreads();
    if (use_grp) {
        volatile LAS unsigned* flagw = xst + 2;
        if (tid < 64) { const unsigned mine = xb_xcc_id() + 1u; const unsigned v = (tid < 32) ? __hip_atomic_load((unsigned*)ws + 9216 + (bx & 7) + 8 * tid, __ATOMIC_RELAXED, __HIP_MEMORY_SCOPE_AGENT) : mine;
            const bool ok = __all(v == mine) != 0; if (tid == 0) *flagw = ok ? 1u : 0u; }
        __syncthreads();
        gbar.local = (*flagw != 0u);
    }

    GROUP_BAR();

    {
        pg8::Gemm g{(const char*)dout, (const char*)WINT, 16, 2048u, 2048u, 128u * 2048u, 128u * 2048u, 128u, 128u};
        pg8::StaticOrder S; S.init(M, NPAD, G, bx, (size_t)256 * 2048, (size_t)256 * 2048, DO_BATCH);
        EpiProj E{ws, conv_w, conv_b};
        const int rounds_full = S.nwg / G, tail = S.nwg - rounds_full * G;
        const bool split = use_grp && tail != 0 && (tail % 8) == 0 && (G - tail) >= 64;
        if (split) S.lim = rounds_full * G;
        pg8::gemm_phase<EpiProj, pg8::StaticOrder, true>(lds, g, S, E);
        GROUP_BAR();
        const bool has_tail = split && bx < tail;
        if (has_tail) { S.i0 = rounds_full; S.lim = S.nwg; pg8::gemm_phase<EpiProj, pg8::StaticOrder, true>(lds, g, S, E); }
        else {
            const int FG = split ? G - tail : G, fbx = split ? bx - tail : bx;
            pg8::Gemm g2{(const char*)(ws + WS_KV), (const char*)(ws + WS_W1S), 16, 8192u, 4096u, 128u, 128u * 4096u, 512u, 128u};
            pg8::CmpOrder S2{FG, fbx};
            EpiCmp E2{(float*)dout};
            pg8::gemm_phase<EpiCmp, pg8::CmpOrder, false>(lds, g2, S2, E2);
            const bf16_t* UC = (const bf16_t*)(ws + WS_UC); bf16_t* GT = (bf16_t*)(ws + WS_GATE);
            for (int idx = fbx * 512 + tid; idx < (M / 32) * 128; idx += FG * 512) {
                const int vb = idx >> 9, b = vb & 7, item = (vb >> 3) * 512 + (idx & 511);
                const int rl = item >> 7, c8 = (item & 127) * 8; const int run = b * 32 + (rl >> 1), q = rl & 1; const int row = run * 64 + q; const bool first = (run & 31) == 0;
                const u32x4 z4 = (u32x4){0u, 0u, 0u, 0u};
                const u32x4 u2 = *(const u32x4*)(UC + (size_t)(run * 4 + q) * 1024 + c8);
                const u32x4 u1 = q ? *(const u32x4*)(UC + (size_t)(run * 4 + 0) * 1024 + c8) : (first ? z4 : *(const u32x4*)(UC + (size_t)((run - 1) * 4 + 3) * 1024 + c8));
                const u32x4 u0 = first ? z4 : *(const u32x4*)(UC + (size_t)((run - 1) * 4 + (q ? 3 : 2)) * 1024 + c8);
                const u32x4 gt = *(const u32x4*)(GT + (size_t)row * 1024 + c8);
                u32x4 ow;
#pragma unroll
                for (int e = 0; e < 4; ++e) {
                    const int c = c8 + 2 * e;
                    const float y0 = conv_b[c] + conv_w[c] * bf_lo(u0[e]) + conv_w[1024 + c] * bf_lo(u1[e]) + conv_w[2048 + c] * bf_lo(u2[e]);
                    const float y1 = conv_b[c + 1] + conv_w[c + 1] * bf_hi(u0[e]) + conv_w[1024 + c + 1] * bf_hi(u1[e]) + conv_w[2048 + c + 1] * bf_hi(u2[e]);
                    ow[e] = cvtpk(bf_lo(gt[e]) * y0, bf_hi(gt[e]) * y1);
                }
                *(u32x4*)(GT + (size_t)row * 1024 + c8) = ow;
            }
        }
    }
    GROUP_BAR();

    {
        LAS float* W2L = (LAS float*)lds; LAS float* HIDL = (LAS float*)(lds + 32768);
        for (int it = bx; it < 512; it += G) {
            const int b = it & 7, kvs = (it >> 3) >> 5, rbl = (it >> 3) & 31; const float* w2 = kvs ? w2_v : w2_k;
            const float* PARTB = (const float*)(dout + (size_t)b * DO_BATCH + DO_PART);
            __syncthreads();
#pragma unroll
            for (int q4 = 0; q4 < 4; ++q4) ((LAS f32x4*)W2L)[tid + 512 * q4] = ((const f32x4*)w2)[tid + 512 * q4];
            { const int row = tid >> 5, hc = (tid & 31) * 4; f32x4 s = *(const f32x4*)((const float*)(ws + WS_PEB) + kvs * 128 + hc);
#pragma unroll
                for (int ks = 0; ks < 2; ++ks) s += *(const f32x4*)(PARTB + ((size_t)(kvs * 2 + ks) * 512 + rbl * 16 + row) * 128 + hc);
                for (int e = 0; e < 4; ++e) s[e] = silu(s[e]);
                *(LAS f32x4*)(HIDL + row * 128 + hc) = s; }
            __syncthreads();
            { const int row = tid >> 5, d = (tid & 31) * 2; float a0 = 0.f, a1 = 0.f;
#pragma unroll 8
                for (int jj = 0; jj < 128; ++jj) { const float hv = HIDL[row * 128 + jj]; const f32x2 w = *(LAS f32x2*)(W2L + jj * 64 + d); a0 += hv * w.x; a1 += hv * w.y; }
                const int grow = b * 512 + rbl * 16 + row; if ((grow & 127) == 127) { a0 = 0.f; a1 = 0.f; }
                *(unsigned*)((bf16_t*)(ws + (kvs ? WS_VC : WS_KC)) + (size_t)grow * 64 + d) = cvtpk(a0, a1); }
        }
    }
    GROUP_BAR();

    {
        AttnP P{(const bf16_t*)(ws + WS_Q), ws + WS_KV, (const bf16_t*)(ws + WS_KC), (const bf16_t*)(ws + WS_VC), (const float*)(ws + WS_GNSA), (bf16_t*)(ws + WS_ZB)};
#define ATT_DECODE(K_, B_, G_, I_) do { const int slot_ = (K_) >> 8, v_ = (K_) & 255, bg_ = v_ >> 3, s_ = v_ & 7; \
            I_ = slot_ == 0 ? s_ : slot_ == 1 ? 15 - s_ : slot_ == 2 ? 16 + s_ : 31 - s_; B_ = bg_ >> 2; G_ = bg_ & 3; } while (0)
        int k = vcu, ub = 0, ug = 0, ui = 0;
        if (k < 1024) { ATT_DECODE(k, ub, ug, ui); attn_prefetch(P, lds, ub, ug, ui); }
        for (; k < 1024; k += G) {
            const bool has_next = (k + G) < 1024; int nb = 0, ng = 0, ni = 0;
            if (has_next) ATT_DECODE(k + G, nb, ng, ni);
            __syncthreads();
            attn_unit(P, lds, ub, ug, ui, has_next, nb, ng, ni);
            ub = nb; ug = ng; ui = ni;
        }
#undef ATT_DECODE
    }
    GROUP_BAR();

    {
        pg8::PairOrder S; S.so.init(M, 1024, G, bx, (size_t)256 * 2048, (size_t)256 * 2048); S.a0 = WS_GATE; S.a1 = WS_ZB; S.b0 = WS_WA; S.b1 = WS_WB;
        pg8::Gemm g{(const char*)ws, (const char*)ws, 16, 2048u, 2048u, 128u * 2048u, 128u * 2048u, 128u, 128u};
        EpiPair E{(const bf16_t*)(ws + WS_G0), (bf16_t*)(ws + WS_G1)};
        pg8::gemm_phase<EpiPair, pg8::PairOrder, true>(lds, g, S, E);
    }
    GROUP_BAR();

    {
        pg8::StaticOrder S; S.init(M, 1024, G, bx, (size_t)256 * 2048, (size_t)256 * 2048);
        pg8::Gemm g{(const char*)(ws + WS_G1), (const char*)(ws + WS_WO), 16, 2048u, 2048u, 128u * 2048u, 128u * 2048u, 128u, 128u};
        if (G == 256) {
            EpiOutNorm E{x, args.out, fnw, (float*)(ws + WS_X), (unsigned*)ws + 4096};
            pg8::gemm_phase<EpiOutNorm, pg8::StaticOrder, false>(lds, g, S, E);
        } else {
            EpiOut E{x, args.out}; pg8::gemm_phase<EpiOut, pg8::StaticOrder, true>(lds, g, S, E);
            GRID_BAR();
            for (int m = gw; m < M; m += NGW) {
                f32x4* xr = (f32x4*)(args.out + (size_t)m * D) + lane; f32x4 v[4]; float sq = 0.f;
#pragma unroll
                for (int j = 0; j < 4; ++j) { v[j] = xr[64 * j]; sq += (v[j].x * v[j].x + v[j].y * v[j].y) + (v[j].z * v[j].z + v[j].w * v[j].w); }
                const float rs = 1.0f / sqrtf(wave_sum(sq) * (1.f / D) + NORM_EPS);
#pragma unroll
                for (int j = 0; j < 4; ++j) { const f32x4 w = ((const f32x4*)fnw)[lane + 64 * j]; xr[64 * j] = (f32x4){v[j].x * rs * w.x, v[j].y * rs * w.y, v[j].z * rs * w.z, v[j].w * rs * w.w}; }
            }
        }
    }
}

extern "C" void kernel_launch(void* const* d_in, const int* in_sizes, int n_in, void* d_out, int out_size, void* d_ws, size_t ws_size, hipStream_t stream) {
    static int grid = 0;
    if (grid == 0) {
        if (n_in != 15 || out_size != M * D || ws_size < WS_END) { fprintf(stderr, "kernel_launch: unexpected problem (n_in %d, out %d, ws %zu)\n", n_in, out_size, ws_size); grid = -1; return; }
        int dev = 0, cus = 0, per_cu = 0;
        hipGetDevice(&dev); hipDeviceGetAttribute(&cus, hipDeviceAttributeMultiprocessorCount, dev);
        if (hipFuncSetAttribute((const void*)fwd_kernel, hipFuncAttributeMaxDynamicSharedMemorySize, LDS_BYTES) != hipSuccess) { fprintf(stderr, "kernel_launch: hipFuncSetAttribute failed\n"); grid = -1; return; }
        if (hipOccupancyMaxActiveBlocksPerMultiprocessor(&per_cu, (const void*)fwd_kernel, 512, LDS_BYTES) != hipSuccess || per_cu < 1) { fprintf(stderr, "kernel_launch: occupancy query says %d\n", per_cu); per_cu = 1; }
        (void)hipGetLastError();
        grid = cus;
    }
    if (grid < 0) return;
    if (hipMemsetAsync(d_ws, 0, 65536, stream) != hipSuccess) { fprintf(stderr, "kernel_launch: memset of the barrier words failed\n"); return; }
    Args a{};
    for (int i = 0; i < 15; ++i) a.in[i] = (const float*)d_in[i];
    a.out = (float*)d_out; a.ws = (unsigned char*)d_ws;
    void* kargs[] = {&a};
    hipError_t e = hipLaunchCooperativeKernel((const void*)fwd_kernel, dim3(grid), dim3(512), kargs, LDS_BYTES, stream);
    if (e != hipSuccess) fprintf(stderr, "cooperative launch failed: %s (grid %d)\n", hipGetErrorString(e), grid);
}
```

```cpp
#include <hip/hip_runtime.h>
#include <hip/hip_cooperative_groups.h>
#include <cstdio>
#include <cstdint>
namespace cg = cooperative_groups;

#define LAS __attribute__((address_space(3)))
typedef unsigned short bf16_t;
typedef short bf16x8 __attribute__((ext_vector_type(8)));
typedef short s16x4 __attribute__((ext_vector_type(4)));
typedef float f32x2 __attribute__((ext_vector_type(2)));
typedef float f32x4 __attribute__((ext_vector_type(4)));
typedef float f32x16 __attribute__((ext_vector_type(16)));
typedef unsigned u32x2 __attribute__((ext_vector_type(2)));
typedef unsigned u32x4 __attribute__((ext_vector_type(4)));
typedef __bf16 bf16x2_t __attribute__((ext_vector_type(2)));

constexpr int NB = 8, T = 2048, D = 1024, M = NB * T;
constexpr int NIN = 9776, NPAD = 9984;
constexpr float NORM_EPS = 1e-6f;
constexpr float LOG2E = 1.4426950408889634f;
constexpr float QSCALE = 0.125f * LOG2E;

constexpr size_t MiB = 1u << 20;
constexpr size_t WS_UC = 1 * MiB;
constexpr size_t WS_WINT = 3 * MiB;
constexpr size_t WS_GATE = 33 * MiB;
constexpr size_t WS_Q = 65 * MiB;
constexpr size_t WS_KV = 97 * MiB;
constexpr size_t KVARR = (size_t)M * 256 * 2;
constexpr size_t WS_ZB = 145 * MiB;
constexpr size_t WS_G0 = 177 * MiB;
constexpr size_t WS_G1 = 209 * MiB;
constexpr size_t WS_GNSA = 241 * MiB;
constexpr size_t WS_KC = 244 * MiB;
constexpr size_t WS_VC = WS_KC + 512 * 1024;
constexpr size_t WS_WA = 245 * MiB, WS_WB = 247 * MiB, WS_WO = 249 * MiB;
constexpr size_t WS_W1S = 251 * MiB;
constexpr size_t WS_PEB = 253 * MiB;
constexpr size_t WS_X = 254 * MiB;
constexpr size_t WS_END = 255 * MiB;
constexpr size_t DO_BATCH = 8 * MiB, DO_PART = 4 * MiB;

constexpr int LDS_BYTES = 139264;

namespace pg8 {
constexpr int BM = 256, BK = 64, HALF = 128, HTB = HALF * BK * 2, STAGE_BYTES = 8 * HTB, NXCD = 8, WGM = 8;
__host__ __device__ __forceinline__ int lds_byte(int r, int c) { const int st = (r >> 4) * 2 + (c >> 5), rr = r & 15, cc = c & 31, ob = rr * 64 + cc * 2; return st * 1024 + (ob ^ (((ob >> 9) & 1) << 5)); }
__host__ __device__ __forceinline__ void stage_rc(int b, int& R, int& C) { const int st = b / 1024, sb = b % 1024, swz = sb ^ (((sb >> 9) & 1) << 5); R = (st >> 1) * 16 + swz / 64; C = (st & 1) * 32 + (swz % 64) / 2; }
__host__ __device__ __forceinline__ int perm32(int rho) { const int n = rho >> 4, i = rho & 15; return 8 * (i >> 2) + 4 * n + (i & 3); }

struct Unit { int pm, pn, aux; };
struct Gemm { const char* A; const char* Bt; int nt; unsigned a_row, b_row, a_half, b_half, a_k, b_k; };

struct StaticOrder {
    int nM, nN, nwg, G, c, i0, lim; size_t tA, tB, aHi;
    __device__ void init(int M_, int N_, int G_, int c_, size_t tA_, size_t tB_, size_t aHi_ = 0) { nM = M_ / BM; nN = N_ / BM; nwg = nM * nN; G = G_; c = c_; tA = tA_; tB = tB_; aHi = aHi_; i0 = 0; lim = nwg; }
    __device__ bool next(int i, Unit& u) const {
        const long L = (long)(i + i0) * G + c; if (L >= lim) return false;
        int wgid = (int)L; { const int q = nwg / NXCD, r = nwg % NXCD, xcd = wgid % NXCD, off = wgid / NXCD; wgid = (xcd < r ? xcd * (q + 1) : r * (q + 1) + (xcd - r) * q) + off; }
        const int nig = WGM * nN, gid = wgid / nig, fm = gid * WGM, gsz = (nM - fm) < WGM ? (nM - fm) : WGM;
        u.pm = fm + ((wgid % nig) % gsz); u.pn = (wgid % nig) / gsz; u.aux = 0; return true;
    }
    __device__ __forceinline__ size_t offA(const Unit& u) const { return aHi ? (size_t)(u.pm >> 3) * aHi + (size_t)(u.pm & 7) * tA : (size_t)u.pm * tA; }
    __device__ __forceinline__ size_t offB(const Unit& u) const { return (size_t)u.pn * tB; }
};

struct PairOrder {
    StaticOrder so; size_t a0, a1, b0, b1;
    __device__ bool next(int i, Unit& u) const { if (!so.next(i >> 1, u)) return false; u.aux = i & 1; return true; }
    __device__ __forceinline__ size_t offA(const Unit& u) const { return (u.aux ? a1 : a0) + (size_t)u.pm * so.tA; }
    __device__ __forceinline__ size_t offB(const Unit& u) const { return (u.aux ? b1 : b0) + (size_t)u.pn * so.tB; }
};
struct CmpOrder {
    int G, c;
    __device__ bool next(int i, Unit& u) const {
        const int L = i * G + c; if (L >= 64) return false;
        const int b = L & 7, idx = L >> 3; u.aux = idx >> 2; u.pn = (idx >> 1) & 1; u.pm = b * 2 + (idx & 1); return true;
    }
    __device__ __forceinline__ size_t offA(const Unit& u) const { return (size_t)u.aux * KVARR + (size_t)(u.pm >> 1) * (2048u * 512u) + (size_t)(u.pm & 1) * 256u + (size_t)u.pn * 8192u; }
    __device__ __forceinline__ size_t offB(const Unit& u) const { return (size_t)u.aux * (128u * 4096u) + (size_t)u.pn * 2048u; }
};

template <class Epi, class Sched, bool ALIGN_EPI>
__device__ __forceinline__ void gemm_phase(LAS unsigned char* lds, const Gemm g, const Sched& S, const Epi& E) {
    const int tid = threadIdx.x, wid = __builtin_amdgcn_readfirstlane(tid >> 6), lane = tid & 63, wr = wid >> 2, wc = wid & 3, fr = lane & 15, fq = lane >> 4;
    const int nt = g.nt;
    unsigned voffA[2], voffB[2];
#pragma unroll
    for (int i = 0; i < 2; ++i) { int R, C; stage_rc(tid * 16 + i * 8192, R, C); const int Rb = Epi::PERM ? ((R & ~31) + perm32(R & 31)) : R;
        voffA[i] = (unsigned)R * g.a_row + (unsigned)C * 2u; voffB[i] = (unsigned)Rb * g.b_row + (unsigned)C * 2u; }
    const size_t kA = g.a_k, kB = g.b_k, hA = g.a_half, hB = g.b_half;
    const unsigned ldsw = (unsigned)wid * 1024u;
    const int aoff = lds_byte(wr * 64 + fr, fq * 8), boff = lds_byte(wc * 32 + fr, fq * 8);
#define PG8_SA(b, h) (((b) * 2 + (h)) * HTB)
#define PG8_SB(b, h) ((4 + (b) * 2 + (h)) * HTB)
#define PG8_STAGE(bufoff, gbase, voff) do { _Pragma("unroll") for (int _i = 0; _i < 2; ++_i) \
        __builtin_amdgcn_global_load_lds((const unsigned*)((const char*)(gbase) + (voff)[_i]), (LAS unsigned*)(lds + (bufoff) + ldsw + _i * 8192), 16, 0, 0); } while (0)
#define PG8_LDA(dst, b, h) do { _Pragma("unroll") for (int m = 0; m < 4; ++m) _Pragma("unroll") for (int k = 0; k < 2; ++k) dst[m][k] = *(const LAS bf16x8*)(lds + PG8_SA(b, h) + aoff + m * 2048 + k * 1024); } while (0)
#define PG8_LDB(dst, b, h) do { _Pragma("unroll") for (int n = 0; n < 2; ++n) _Pragma("unroll") for (int k = 0; k < 2; ++k) dst[n][k] = *(const LAS bf16x8*)(lds + PG8_SB(b, h) + boff + n * 2048 + k * 1024); } while (0)
#define PG8_MMA(ai, bj, At, Bt) do { __builtin_amdgcn_s_setprio(1); _Pragma("unroll") for (int m = 0; m < 4; ++m) _Pragma("unroll") for (int n = 0; n < 2; ++n) _Pragma("unroll") for (int k = 0; k < 2; ++k) \
        acc[ai][bj][m][n] = __builtin_amdgcn_mfma_f32_16x16x32_bf16(Bt[n][k], At[m][k], acc[ai][bj][m][n], 0, 0, 0); __builtin_amdgcn_s_setprio(0); } while (0)
#define PG8_WAIT_V(n) asm volatile("s_waitcnt vmcnt(" #n ")" ::: "memory")
#define PG8_WAIT_L(n) asm volatile("s_waitcnt lgkmcnt(" #n ")" ::: "memory")
#define PG8_BAR __builtin_amdgcn_s_barrier()
#define PG8_SCHED __builtin_amdgcn_sched_barrier(0)
    Unit cur, nxt; int ui = 0;
    if (!S.next(0, cur)) return;
    f32x4 acc[2][2][4][2];
#pragma unroll
    for (int a = 0; a < 2; ++a)
#pragma unroll
        for (int b = 0; b < 2; ++b)
#pragma unroll
            for (int m = 0; m < 4; ++m)
#pragma unroll
                for (int n = 0; n < 2; ++n) acc[a][b][m][n] = (f32x4){0.f, 0.f, 0.f, 0.f};
    bf16x8 At[4][2], B0[2][2], B1[2][2];
    const char* cA = g.A + S.offA(cur); const char* cB = g.Bt + S.offB(cur);
    PG8_STAGE(PG8_SB(0, 0), cB, voffB); PG8_STAGE(PG8_SB(0, 1), cB + hB, voffB); PG8_STAGE(PG8_SA(0, 0), cA, voffA); PG8_STAGE(PG8_SA(0, 1), cA + hA, voffA);
    if (wr == 1) PG8_BAR;
    PG8_WAIT_V(2); PG8_BAR;
    PG8_STAGE(PG8_SB(1, 0), cB + kB, voffB); PG8_STAGE(PG8_SA(1, 0), cA + kA, voffA); PG8_STAGE(PG8_SB(1, 1), cB + hB + kB, voffB);
    PG8_WAIT_V(6); PG8_BAR;
    for (;;) {
        const bool has_next = S.next(ui + 1, nxt);
        const char* nA = has_next ? g.A + S.offA(nxt) : cA; const char* nB = has_next ? g.Bt + S.offB(nxt) : cB;
        for (int t = 0; t < nt; t += 2) {
            const bool last = (t == nt - 2);
            const char* a1 = cA + (size_t)(t + 1) * kA;
            const char* a2 = last ? nA : cA + (size_t)(t + 2) * kA; const char* b2 = last ? nB : cB + (size_t)(t + 2) * kB;
            const char* a3 = a2 + kA; const char* b3 = b2 + kB;
            PG8_LDB(B0, 0, 0); PG8_LDB(B1, 0, 1); PG8_SCHED; PG8_LDA(At, 0, 0); PG8_STAGE(PG8_SA(1, 1), a1 + hA, voffA);
            PG8_WAIT_V(8); PG8_WAIT_L(0); PG8_BAR; PG8_MMA(0, 0, At, B0); PG8_MMA(0, 1, At, B1); PG8_BAR; PG8_SCHED;
            PG8_LDA(At, 0, 1); PG8_STAGE(PG8_SB(0, 0), b2, voffB); PG8_STAGE(PG8_SB(0, 1), b2 + hB, voffB); PG8_STAGE(PG8_SA(0, 0), a2, voffA);
            PG8_WAIT_V(8); PG8_WAIT_L(0); PG8_BAR; PG8_MMA(1, 0, At, B0); PG8_MMA(1, 1, At, B1); PG8_BAR; PG8_SCHED;
            PG8_LDB(B0, 1, 0); PG8_LDB(B1, 1, 1); PG8_SCHED; PG8_LDA(At, 1, 0); PG8_STAGE(PG8_SA(0, 1), a2 + hA, voffA);
            PG8_WAIT_V(8); PG8_WAIT_L(0); PG8_BAR; PG8_MMA(0, 0, At, B0); PG8_MMA(0, 1, At, B1); PG8_BAR; PG8_SCHED;
            PG8_LDA(At, 1, 1); PG8_STAGE(PG8_SB(1, 0), b3, voffB); PG8_STAGE(PG8_SB(1, 1), b3 + hB, voffB); PG8_STAGE(PG8_SA(1, 0), a3, voffA);
            PG8_WAIT_V(8); PG8_WAIT_L(0); PG8_BAR; PG8_MMA(1, 0, At, B0); PG8_MMA(1, 1, At, B1); PG8_BAR; PG8_SCHED;
        }
        if constexpr (ALIGN_EPI) { if (wr == 0) PG8_BAR; }
        bool keep = false;
        if constexpr (Epi::CHAIN) keep = E.chain(acc, cur, wr, wc, fr, fq);
        else if constexpr (!Epi::AFTER_DRAIN) E(acc, cur, wr, wc, fr, fq);
        if (!has_next) break;
        if (!keep)
#pragma unroll
        for (int a = 0; a < 2; ++a)
#pragma unroll
            for (int b = 0; b < 2; ++b)
#pragma unroll
                for (int m = 0; m < 4; ++m)
#pragma unroll
                    for (int n = 0; n < 2; ++n) acc[a][b][m][n] = (f32x4){0.f, 0.f, 0.f, 0.f};
        cur = nxt; cA = nA; cB = nB; ++ui;
        if constexpr (ALIGN_EPI) { if (wr == 1) PG8_BAR; }
    }
    PG8_WAIT_V(0);
    if constexpr (!ALIGN_EPI) { if (wr == 0) PG8_BAR; }
    PG8_BAR;
    if constexpr (Epi::AFTER_DRAIN) E.fused(acc, cur, wr, wc, fr, fq, lds, wid, lane);
#undef PG8_SA
#undef PG8_SB
#undef PG8_STAGE
#undef PG8_LDA
#undef PG8_LDB
#undef PG8_MMA
#undef PG8_WAIT_V
#undef PG8_WAIT_L
#undef PG8_BAR
#undef PG8_SCHED
}
}

__device__ __forceinline__ unsigned cvtpk(float lo, float hi) { f32x2 v = {lo, hi}; bf16x2_t b = __builtin_convertvector(v, bf16x2_t); return __builtin_bit_cast(unsigned, b); }
__device__ __forceinline__ float bf_lo(unsigned w) { return __builtin_bit_cast(float, w << 16); }
__device__ __forceinline__ float bf_hi(unsigned w) { return __builtin_bit_cast(float, w & 0xffff0000u); }
__device__ __forceinline__ float sigm(float x) { return __builtin_amdgcn_rcpf(1.f + __expf(-x)); }
__device__ __forceinline__ float silu(float x) { return x * __builtin_amdgcn_rcpf(1.f + __expf(-x)); }
__device__ __forceinline__ float wave_sum(float v) {
#pragma unroll
    for (int o = 1; o < 64; o <<= 1) v += __shfl_xor(v, o);
    return v;
}
__device__ __forceinline__ int crow(int r, int hi) { return (r & 3) + 8 * (r >> 2) + 4 * hi; }


__device__ __forceinline__ float dpp_ror1(float v) { return __builtin_bit_cast(float, __builtin_amdgcn_update_dpp(0, __builtin_bit_cast(int, v), 0x121, 0xf, 0xf, false)); }
__device__ __forceinline__ float dpp_ror2(float v) { return __builtin_bit_cast(float, __builtin_amdgcn_update_dpp(0, __builtin_bit_cast(int, v), 0x122, 0xf, 0xf, false)); }
__device__ __forceinline__ float dpp_shr1(float old, float v) { return __builtin_bit_cast(float, __builtin_amdgcn_update_dpp(__builtin_bit_cast(int, old), __builtin_bit_cast(int, v), 0x111, 0xf, 0xf, false)); }
__device__ __forceinline__ float dpp_shr2(float old, float v) { return __builtin_bit_cast(float, __builtin_amdgcn_update_dpp(__builtin_bit_cast(int, old), __builtin_bit_cast(int, v), 0x112, 0xf, 0xf, false)); }


__device__ __forceinline__ int dpp_x1(int v) { return __builtin_amdgcn_update_dpp(0, v, 0xB1, 0xf, 0xf, false); }
__device__ __forceinline__ int dpp_x2(int v) { return __builtin_amdgcn_update_dpp(0, v, 0x4E, 0xf, 0xf, false); }
__device__ __forceinline__ int dpp_x4(int v, bool lowq) { const int up = __builtin_amdgcn_update_dpp(0, v, 0x12C, 0xf, 0xf, false), dn = __builtin_amdgcn_update_dpp(0, v, 0x124, 0xf, 0xf, false); return lowq ? up : dn; }

__device__ __forceinline__ int map_in(int v) {
    const int pn = v >> 8, j = v & 255;
    if (pn < 16) { const int bj = j >> 7, jj = j & 127, wc = jj >> 5, fq = (jj & 31) >> 3, n = (jj & 7) >> 2, e = jj & 3;
        const int sel = bj * 2 + n; const int off = sel == 0 ? 0 : sel == 1 ? 2048 : sel == 2 ? 1024 : 3072;
        return off + pn * 64 + wc * 16 + fq * 4 + e; }
    if (pn < 20) return 4096 + (pn - 16) * 256 + j;
    if (pn < 26) return 5120 + (pn - 20) * 256 + j;
    if (pn < 30) return 6704 + (pn - 26) * 256 + j;
    if (pn < 38) return 7728 + (j >> 7) * 1024 + (pn - 30) * 128 + (j & 127);
    return j < 48 ? 6656 + j : -1;
}

struct EpiProj {
    static constexpr bool PERM = true, AFTER_DRAIN = false, CHAIN = false;
    unsigned char* ws; const float* conv_w; const float* conv_b;
    __device__ __forceinline__ void operator()(const f32x4 (&acc)[2][2][4][2], const pg8::Unit& u, int wr, int wc, int fr, int fq) const {
        const int pn = u.pn; const int row0 = u.pm * 256 + wr * 64 + fr;
        if (pn < 16) {
            bf16_t* UC = (bf16_t*)(ws + WS_UC); bf16_t* GT = (bf16_t*)(ws + WS_GATE); const int ch = pn * 64 + wc * 16 + fq * 4;
            const f32x4 w0 = *(const f32x4*)(conv_w + ch), w1 = *(const f32x4*)(conv_w + 1024 + ch), w2 = *(const f32x4*)(conv_w + 2048 + ch), cbv = *(const f32x4*)(conv_b + ch);
#pragma unroll
            for (int ai = 0; ai < 2; ++ai) {
                f32x4 up = (f32x4){0.f, 0.f, 0.f, 0.f};
#pragma unroll
                for (int m = 0; m < 4; ++m) { const size_t o = (size_t)(row0 + ai * 128 + m * 16) * 1024 + ch;
                    const f32x4 h4 = acc[ai][0][m][0], c4 = acc[ai][0][m][1], b4 = acc[ai][1][m][0], z4 = acc[ai][1][m][1];
                    const f32x4 u4 = h4 * c4; f32x4 g4, y4;
#pragma unroll
                    for (int e = 0; e < 4; ++e) { g4[e] = b4[e] * silu(z4[e]);
                        const float p1 = dpp_shr1(dpp_ror1(up[e]), u4[e]), p2 = dpp_shr2(dpp_ror2(up[e]), u4[e]);
                        y4[e] = g4[e] * (cbv[e] + w0[e] * p2 + w1[e] * p1 + w2[e] * u4[e]); }
                    const bool head = (m == 0) && (fr < 2);
                    u32x2 gg; gg.x = head ? cvtpk(g4[0], g4[1]) : cvtpk(y4[0], y4[1]); gg.y = head ? cvtpk(g4[2], g4[3]) : cvtpk(y4[2], y4[3]);
                    *(u32x2*)(GT + o) = gg;
                    if (head || (m == 3 && fr >= 14)) { u32x2 uu; uu.x = cvtpk(u4[0], u4[1]); uu.y = cvtpk(u4[2], u4[3]);
                        const int run = u.pm * 4 + ai * 2 + wr, slot = head ? fr : fr - 12; *(u32x2*)(UC + ((size_t)(run * 4 + slot)) * 1024 + ch) = uu; }
                    up = u4; }
            }
        } else if (pn >= 30 && pn < 38) {
            bf16_t* R0 = (bf16_t*)(ws + WS_G0); bf16_t* R1 = (bf16_t*)(ws + WS_G1); const int col0 = (pn - 30) * 128 + wc * 32 + fq * 8;
#pragma unroll
            for (int ai = 0; ai < 2; ++ai)
#pragma unroll
                for (int m = 0; m < 4; ++m) { const size_t o = (size_t)(row0 + ai * 128 + m * 16) * 1024 + col0; float rr[8], s1[8];
#pragma unroll
                    for (int e = 0; e < 8; ++e) { const float x0 = acc[ai][0][m][e >> 2][e & 3], x1 = acc[ai][1][m][e >> 2][e & 3];
                        const float e0 = 1.f + __expf(-x0), e1 = 1.f + __expf(-x1); s1[e] = __builtin_amdgcn_rcpf(e1); rr[e] = e1 * __builtin_amdgcn_rcpf(e0); }
                    u32x4 w0, w1; w0.x = cvtpk(rr[0], rr[1]); w0.y = cvtpk(rr[2], rr[3]); w0.z = cvtpk(rr[4], rr[5]); w0.w = cvtpk(rr[6], rr[7]);
                    w1.x = cvtpk(s1[0], s1[1]); w1.y = cvtpk(s1[2], s1[3]); w1.z = cvtpk(s1[4], s1[5]); w1.w = cvtpk(s1[6], s1[7]);
                    *(u32x4*)(R0 + o) = w0; *(u32x4*)(R1 + o) = w1; }
        } else if (pn < 38) {
            bf16_t* dst; int ld; int mode;
            if (pn < 20) { dst = (bf16_t*)(ws + WS_Q) + (pn - 16) * 256; ld = 1024; mode = 0; }
            else if (pn < 26) { dst = (bf16_t*)(ws + WS_KV + (size_t)(pn - 20) * KVARR); ld = 256; mode = 1; }
            else { dst = (bf16_t*)(ws + WS_ZB) + (pn - 26) * 256; ld = 1024; mode = 2; }
            const int col0 = wc * 32 + fq * 8;
#pragma unroll
            for (int ai = 0; ai < 2; ++ai)
#pragma unroll
                for (int m = 0; m < 4; ++m) { bf16_t* rowp = dst + (size_t)(row0 + ai * 128 + m * 16) * ld + col0;
#pragma unroll
                    for (int bj = 0; bj < 2; ++bj) { f32x4 v0 = acc[ai][bj][m][0], v1 = acc[ai][bj][m][1];
                        if (mode == 0) { v0 = v0 * QSCALE; v1 = v1 * QSCALE; }
                        else if (mode == 2) { for (int e = 0; e < 4; ++e) { v0[e] = silu(v0[e]); v1[e] = silu(v1[e]); } }
                        else if (mode == 3) { for (int e = 0; e < 4; ++e) { v0[e] = sigm(v0[e]); v1[e] = sigm(v1[e]); } }
                        u32x4 w; w.x = cvtpk(v0[0], v0[1]); w.y = cvtpk(v0[2], v0[3]); w.z = cvtpk(v1[0], v1[1]); w.w = cvtpk(v1[2], v1[3]);
                        *(u32x4*)(rowp + bj * 128) = w; } }
        } else {
            float* GN = (float*)(ws + WS_GNSA); const int col0 = wc * 32 + fq * 8;
            if (col0 < 48) {
#pragma unroll
                for (int ai = 0; ai < 2; ++ai)
#pragma unroll
                    for (int m = 0; m < 4; ++m) { float* rp = GN + (size_t)(row0 + ai * 128 + m * 16) * 48 + col0;
                        f32x4 v0 = acc[ai][0][m][0], v1 = acc[ai][0][m][1];
                        for (int e = 0; e < 4; ++e) { v0[e] = sigm(v0[e]); v1[e] = sigm(v1[e]); }
                        *(f32x4*)rp = v0; *(f32x4*)(rp + 4) = v1; }
            }
        }
    }
};
struct EpiCmp {
    static constexpr bool PERM = false, AFTER_DRAIN = false, CHAIN = false;
    float* part;
    __device__ __forceinline__ void operator()(const f32x4 (&acc)[2][2][4][2], const pg8::Unit& u, int wr, int wc, int fr, int fq) const {
        const int b = u.pm >> 1, gp = u.pm & 1;
        float* base = (float*)((unsigned char*)part + (size_t)b * DO_BATCH + DO_PART) + ((size_t)(u.aux * 2 + u.pn) * 512) * 128;
#pragma unroll
        for (int ai = 0; ai < 2; ++ai)
#pragma unroll
            for (int m = 0; m < 4; ++m) { const int c = wr * 64 + m * 16 + fr; const int row = (gp * 2 + ai) * 128 + c;
#pragma unroll
                for (int n = 0; n < 2; ++n) *(f32x4*)(base + (size_t)row * 128 + wc * 32 + n * 16 + fq * 4) = acc[ai][0][m][n]; }
    }
};
struct EpiYa {
    static constexpr bool PERM = true, AFTER_DRAIN = false, CHAIN = false;
    bf16_t* G0;
    __device__ __forceinline__ void operator()(const f32x4 (&acc)[2][2][4][2], const pg8::Unit& u, int wr, int wc, int fr, int fq) const {
        const int row0 = u.pm * 256 + wr * 64 + fr, col0 = u.pn * 256 + wc * 32 + fq * 8;
#pragma unroll
        for (int ai = 0; ai < 2; ++ai)
#pragma unroll
            for (int m = 0; m < 4; ++m)
#pragma unroll
                for (int bj = 0; bj < 2; ++bj) { bf16_t* p = G0 + (size_t)(row0 + ai * 128 + m * 16) * 1024 + col0 + bj * 128;
                    const u32x4 gv = *(const u32x4*)p; const f32x4 v0 = acc[ai][bj][m][0], v1 = acc[ai][bj][m][1]; u32x4 w;
                    w.x = cvtpk(bf_lo(gv.x) * v0[0], bf_hi(gv.x) * v0[1]); w.y = cvtpk(bf_lo(gv.y) * v0[2], bf_hi(gv.y) * v0[3]);
                    w.z = cvtpk(bf_lo(gv.z) * v1[0], bf_hi(gv.z) * v1[1]); w.w = cvtpk(bf_lo(gv.w) * v1[2], bf_hi(gv.w) * v1[3]);
                    *(u32x4*)p = w; }
    }
};
struct EpiMix {
    static constexpr bool PERM = true, AFTER_DRAIN = false, CHAIN = false;
    const bf16_t* G0; bf16_t* G1;
    __device__ __forceinline__ void operator()(const f32x4 (&acc)[2][2][4][2], const pg8::Unit& u, int wr, int wc, int fr, int fq) const {
        const int row0 = u.pm * 256 + wr * 64 + fr, col0 = u.pn * 256 + wc * 32 + fq * 8;
#pragma unroll
        for (int ai = 0; ai < 2; ++ai)
#pragma unroll
            for (int m = 0; m < 4; ++m)
#pragma unroll
                for (int bj = 0; bj < 2; ++bj) { const size_t o = (size_t)(row0 + ai * 128 + m * 16) * 1024 + col0 + bj * 128;
                    const u32x4 gv = *(const u32x4*)(G1 + o); const u32x4 ya = *(const u32x4*)(G0 + o); const f32x4 v0 = acc[ai][bj][m][0], v1 = acc[ai][bj][m][1]; u32x4 w;
                    w.x = cvtpk(bf_lo(gv.x) * v0[0] + bf_lo(ya.x), bf_hi(gv.x) * v0[1] + bf_hi(ya.x)); w.y = cvtpk(bf_lo(gv.y) * v0[2] + bf_lo(ya.y), bf_hi(gv.y) * v0[3] + bf_hi(ya.y));
                    w.z = cvtpk(bf_lo(gv.z) * v1[0] + bf_lo(ya.z), bf_hi(gv.z) * v1[1] + bf_hi(ya.z)); w.w = cvtpk(bf_lo(gv.w) * v1[2] + bf_lo(ya.w), bf_hi(gv.w) * v1[3] + bf_hi(ya.w));
                    *(u32x4*)(G1 + o) = w; }
    }
};

struct EpiPair {
    static constexpr bool PERM = true, AFTER_DRAIN = false, CHAIN = true;
    const bf16_t* G0; bf16_t* G1;
    __device__ __forceinline__ bool chain(f32x4 (&acc)[2][2][4][2], const pg8::Unit& u, int wr, int wc, int fr, int fq) const {
        const int row0 = u.pm * 256 + wr * 64 + fr, col0 = u.pn * 256 + wc * 32 + fq * 8;
        if (u.aux == 0) {
#pragma unroll
            for (int ai = 0; ai < 2; ++ai)
#pragma unroll
                for (int m = 0; m < 4; ++m)
#pragma unroll
                    for (int bj = 0; bj < 2; ++bj) { const size_t o = (size_t)(row0 + ai * 128 + m * 16) * 1024 + col0 + bj * 128;
                        const u32x4 a0 = *(const u32x4*)(G0 + o);
                        const f32x4 r0 = (f32x4){bf_lo(a0.x), bf_hi(a0.x), bf_lo(a0.y), bf_hi(a0.y)}, r1 = (f32x4){bf_lo(a0.z), bf_hi(a0.z), bf_lo(a0.w), bf_hi(a0.w)};
                        acc[ai][bj][m][0] = acc[ai][bj][m][0] * r0; acc[ai][bj][m][1] = acc[ai][bj][m][1] * r1; }
            return true;
        }
#pragma unroll
        for (int ai = 0; ai < 2; ++ai)
#pragma unroll
            for (int m = 0; m < 4; ++m)
#pragma unroll
                for (int bj = 0; bj < 2; ++bj) { const size_t o = (size_t)(row0 + ai * 128 + m * 16) * 1024 + col0 + bj * 128;
                    const u32x4 gv = *(const u32x4*)(G1 + o); const f32x4 v0 = acc[ai][bj][m][0], v1 = acc[ai][bj][m][1]; u32x4 w;
                    w.x = cvtpk(bf_lo(gv.x) * v0[0], bf_hi(gv.x) * v0[1]); w.y = cvtpk(bf_lo(gv.y) * v0[2], bf_hi(gv.y) * v0[3]);
                    w.z = cvtpk(bf_lo(gv.z) * v1[0], bf_hi(gv.z) * v1[1]); w.w = cvtpk(bf_lo(gv.w) * v1[2], bf_hi(gv.w) * v1[3]);
                    *(u32x4*)(G1 + o) = w; }
        return false;
    }
    __device__ __forceinline__ void operator()(const f32x4 (&)[2][2][4][2], const pg8::Unit&, int, int, int, int) const {}
};
struct EpiOut {
    static constexpr bool PERM = true, AFTER_DRAIN = false, CHAIN = false;
    const float* x; float* out;
    __device__ __forceinline__ void operator()(const f32x4 (&acc)[2][2][4][2], const pg8::Unit& u, int wr, int wc, int fr, int fq) const {
        const int row0 = u.pm * 256 + wr * 64 + fr, col0 = u.pn * 256 + wc * 32 + fq * 8;
#pragma unroll
        for (int ai = 0; ai < 2; ++ai)
#pragma unroll
            for (int m = 0; m < 4; ++m)
#pragma unroll
                for (int bj = 0; bj < 2; ++bj) { const size_t o = (size_t)(row0 + ai * 128 + m * 16) * 1024 + col0 + bj * 128;
                    const f32x4 x0 = *(const f32x4*)(x + o), x1 = *(const f32x4*)(x + o + 4);
                    *(f32x4*)(out + o) = x0 + acc[ai][bj][m][0]; *(f32x4*)(out + o + 4) = x1 + acc[ai][bj][m][1]; }
    }
};


struct EpiOutNorm {
    static constexpr bool PERM = true, AFTER_DRAIN = true, CHAIN = false;
    const float* x; float* out; const float* fnw; float* xbuf; unsigned* cnt;
    __device__ __forceinline__ void operator()(const f32x4 (&)[2][2][4][2], const pg8::Unit&, int, int, int, int) const {}
    __device__ __forceinline__ void fused(f32x4 (&acc)[2][2][4][2], const pg8::Unit& u, int wr, int wc, int fr, int fq, LAS unsigned char* lds, int wid, int lane) const {
        const int row0 = u.pm * 256 + wr * 64 + fr, col0 = u.pn * 256 + wc * 32 + fq * 8;
        LAS float* Pp = (LAS float*)lds; LAS float* S = (LAS float*)(lds + 4096);
#pragma unroll
        for (int ai = 0; ai < 2; ++ai)
#pragma unroll
            for (int m = 0; m < 4; ++m) { float ss = 0.f;
#pragma unroll
                for (int bj = 0; bj < 2; ++bj) { const size_t o = (size_t)(row0 + ai * 128 + m * 16) * 1024 + col0 + bj * 128;
                    const f32x4 v0 = *(const f32x4*)(x + o) + acc[ai][bj][m][0], v1 = *(const f32x4*)(x + o + 4) + acc[ai][bj][m][1];
                    acc[ai][bj][m][0] = v0; acc[ai][bj][m][1] = v1;
                    ss += (v0[0] * v0[0] + v0[1] * v0[1]) + (v0[2] * v0[2] + v0[3] * v0[3]) + (v1[0] * v1[0] + v1[1] * v1[1]) + (v1[2] * v1[2] + v1[3] * v1[3]); }
                ss += __shfl_xor(ss, 16); ss += __shfl_xor(ss, 32);
                if (fq == 0) Pp[(ai * 128 + wr * 64 + m * 16 + fr) * 4 + wc] = ss; }
        asm volatile("s_waitcnt lgkmcnt(0)" ::: "memory"); __builtin_amdgcn_s_barrier(); asm volatile("" ::: "memory");
        const int row = wid * 32 + (lane & 31);
        if (lane < 32) { const float t = (Pp[row * 4 + 0] + Pp[row * 4 + 1]) + (Pp[row * 4 + 2] + Pp[row * 4 + 3]);
            __hip_atomic_store(xbuf + (size_t)(u.pm * 256 + row) * 4 + u.pn, t, __ATOMIC_RELAXED, __HIP_MEMORY_SCOPE_AGENT); }
        asm volatile("s_waitcnt vmcnt(0)" ::: "memory");
        if (lane == 0) __hip_atomic_fetch_add(cnt + 64 * u.pm, 1u, __ATOMIC_RELAXED, __HIP_MEMORY_SCOPE_AGENT);
        if (wid == 0) {
            unsigned sp = 0;
            while ((unsigned)__builtin_amdgcn_readfirstlane((int)__hip_atomic_load(cnt + 64 * u.pm, __ATOMIC_RELAXED, __HIP_MEMORY_SCOPE_AGENT)) < 32u) { __builtin_amdgcn_s_sleep(2); if (++sp > (1u << 22)) break; }
            __builtin_amdgcn_fence(__ATOMIC_ACQUIRE, "agent");
        }
        asm volatile("s_waitcnt vmcnt(0) lgkmcnt(0)" ::: "memory"); __builtin_amdgcn_s_barrier(); asm volatile("" ::: "memory");
        if (lane < 32) { const float* slot = xbuf + (size_t)(u.pm * 256 + row) * 4; float t = 0.f;
#pragma unroll
            for (int q = 0; q < 4; ++q) t += __hip_atomic_load(slot + q, __ATOMIC_RELAXED, __HIP_MEMORY_SCOPE_AGENT);
            S[row] = 1.0f / sqrtf(t * (1.f / 1024.f) + NORM_EPS); }
        asm volatile("s_waitcnt lgkmcnt(0)" ::: "memory"); __builtin_amdgcn_s_barrier(); asm volatile("" ::: "memory");
        f32x4 wv[2][2];
#pragma unroll
        for (int bj = 0; bj < 2; ++bj) { wv[bj][0] = *(const f32x4*)(fnw + col0 + bj * 128); wv[bj][1] = *(const f32x4*)(fnw + col0 + bj * 128 + 4); }
#pragma unroll
        for (int ai = 0; ai < 2; ++ai)
#pragma unroll
            for (int m = 0; m < 4; ++m) { const float rs = S[ai * 128 + wr * 64 + m * 16 + fr];
#pragma unroll
                for (int bj = 0; bj < 2; ++bj) { const size_t o = (size_t)(row0 + ai * 128 + m * 16) * 1024 + col0 + bj * 128;
                    *(f32x4*)(out + o) = acc[ai][bj][m][0] * rs * wv[bj][0]; *(f32x4*)(out + o + 4) = acc[ai][bj][m][1] * rs * wv[bj][1]; } }
    }
};

template <class Map>
__device__ __forceinline__ void transpose_item(const float* W, int ldw, int K, int nblk, bf16_t* WT, int row_off, LAS float* scr, int item, int lane, Map map) {
    const int kb = item / nblk, nb = item % nblk, k0 = 64 * kb, n0 = 32 * nb;
    const int src = map(n0 + (lane & 31));
    float tv[32];
    const float* wp = W + (size_t)(k0 + (lane >> 5)) * ldw + (src >= 0 ? src : 0);
#pragma unroll
    for (int i = 0; i < 32; ++i) tv[i] = wp[(size_t)(2 * i) * ldw];
#pragma unroll
    for (int i = 0; i < 32; ++i) { const int kk = 2 * i + (lane >> 5); scr[kk * 33 + (lane & 31)] = src >= 0 ? tv[i] : 0.f; }
    asm volatile("s_waitcnt lgkmcnt(0)" ::: "memory");
    const int c = lane & 7;
#pragma unroll
    for (int j = 0; j < 4; ++j) { const int n = (lane >> 3) + 8 * j; const LAS float* s = scr + (8 * c) * 33 + n;
        u32x4 o; o.x = cvtpk(s[0 * 33], s[1 * 33]); o.y = cvtpk(s[2 * 33], s[3 * 33]); o.z = cvtpk(s[4 * 33], s[5 * 33]); o.w = cvtpk(s[6 * 33], s[7 * 33]);
        *(u32x4*)(WT + (size_t)(row_off + n0 + n) * K + k0 + 8 * c) = o; }
    asm volatile("s_waitcnt lgkmcnt(0)" ::: "memory");
}

template <class RowMap>
__device__ __forceinline__ void transpose_item64(const float* W, int ldw, int ncols, int K, int nblk, bf16_t* WT, LAS float* scr, int item, int lane, RowMap rowmap) {
    const int kb = item / nblk, nb = item % nblk, k0 = 64 * kb, n0 = 64 * nb;
    const int sc = n0 + lane; const bool valid = sc < ncols;
    const float* wp = W + (size_t)k0 * ldw + (valid ? sc : 0);
    float tv[64];
#pragma unroll
    for (int i = 0; i < 64; ++i) tv[i] = wp[(size_t)i * ldw];
#pragma unroll
    for (int i = 0; i < 64; ++i) scr[i * 65 + lane] = tv[i];
    asm volatile("s_waitcnt lgkmcnt(0)" ::: "memory");
    const int c = lane & 7;
#pragma unroll
    for (int j = 0; j < 8; ++j) { const int n = (lane >> 3) + 8 * j, sn = n0 + n; const int row = sn < ncols ? rowmap(sn) : -1; const LAS float* sp = scr + (8 * c) * 65 + n;
        u32x4 o; o.x = cvtpk(sp[0 * 65], sp[1 * 65]); o.y = cvtpk(sp[2 * 65], sp[3 * 65]); o.z = cvtpk(sp[4 * 65], sp[5 * 65]); o.w = cvtpk(sp[6 * 65], sp[7 * 65]);
        if (row >= 0) *(u32x4*)(WT + (size_t)row * K + k0 + 8 * c) = o; }
    asm volatile("s_waitcnt lgkmcnt(0)" ::: "memory");
}
struct RowIn { __device__ __forceinline__ int operator()(int sc) const {
    if (sc < 4096) { const int chunk = sc >> 10, c = sc & 1023; const int bj = chunk & 1, n = chunk >> 1;
        return (c >> 6) * 256 + bj * 128 + ((c >> 4) & 3) * 32 + ((c >> 2) & 3) * 8 + n * 4 + (c & 3); }
    if (sc < 5120) return 16 * 256 + (sc - 4096);
    if (sc < 6656) return 20 * 256 + (sc - 5120);
    if (sc < 6704) return 38 * 256 + (sc - 6656);
    if (sc < 7728) return 26 * 256 + (sc - 6704);
    { const int t = sc - 7728, ch = t & 1023; return (30 + (ch >> 7)) * 256 + (t >> 10) * 128 + (ch & 127); } } };
struct RowOff { int off; __device__ __forceinline__ int operator()(int sc) const { return off + sc; } };
struct MapIn { __device__ __forceinline__ int operator()(int v) const { return map_in(v); } };
struct MapId { __device__ __forceinline__ int operator()(int v) const { return v; } };

constexpr int L_KB = 0, L_VB = 16384, L_KC = 32768, L_VC = 49152, L_IMP = 65536, L_SEL = L_IMP + 4 * 64 * 33 * 4, L_SELU = L_SEL + 256, L_WSF = L_SELU + 256, L_QN = 102400  ;
static_assert(L_WSF + 8 * 64 * 4 <= L_QN && L_QN + 32768 <= LDS_BYTES - 64, "attention LDS map");

__device__ __forceinline__ void qk_tile(f32x16& p0, f32x16& p1, LAS const unsigned char* kt, const bf16x8* qr, int r32, int hi) {
    LAS const unsigned char* kb = kt + hi * 1024 + r32 * 16;
#pragma unroll
    for (int d0 = 0; d0 < 4; ++d0) {
        const bf16x8 b0 = *(LAS const bf16x8*)(kb + d0 * 2048), b1 = *(LAS const bf16x8*)(kb + d0 * 2048 + 512);
        p0 = __builtin_amdgcn_mfma_f32_32x32x16_bf16(b0, qr[d0], p0, 0, 0, 0);
        p1 = __builtin_amdgcn_mfma_f32_32x32x16_bf16(b1, qr[d0], p1, 0, 0, 0);
    }
    __builtin_amdgcn_sched_barrier(0);
}
__device__ __forceinline__ s16x4 vtr(LAS const unsigned char* p) { return __builtin_bit_cast(s16x4, __builtin_amdgcn_ds_read_tr16_b64_v4i16((LAS s16x4*)p)); }
__device__ __forceinline__ void pv_tile(f32x16* o, LAS const unsigned char* vt, int lane, int hi, const f32x16& p0, const f32x16& p1) {
    LAS const unsigned char* vb = vt + ((lane >> 4) & 1) * 32 + (lane & 3) * 8 + (4 * hi + ((lane & 15) >> 2)) * 64;
    u32x4 pw[4];
    pw[0] = (u32x4){cvtpk(p0[0], p0[1]), cvtpk(p0[2], p0[3]), cvtpk(p0[4], p0[5]), cvtpk(p0[6], p0[7])};
    pw[1] = (u32x4){cvtpk(p0[8], p0[9]), cvtpk(p0[10], p0[11]), cvtpk(p0[12], p0[13]), cvtpk(p0[14], p0[15])};
    pw[2] = (u32x4){cvtpk(p1[0], p1[1]), cvtpk(p1[2], p1[3]), cvtpk(p1[4], p1[5]), cvtpk(p1[6], p1[7])};
    pw[3] = (u32x4){cvtpk(p1[8], p1[9]), cvtpk(p1[10], p1[11]), cvtpk(p1[12], p1[13]), cvtpk(p1[14], p1[15])};
    __builtin_amdgcn_sched_barrier(0);
#pragma unroll
    for (int d0 = 0; d0 < 2; ++d0)
#pragma unroll
        for (int ks = 0; ks < 4; ++ks) {
            const s16x4 lo = vtr(vb + d0 * 4096 + ks * 1024), hh = vtr(vb + d0 * 4096 + ks * 1024 + 512);
            const bf16x8 vf = (bf16x8){lo[0], lo[1], lo[2], lo[3], hh[0], hh[1], hh[2], hh[3]};
            o[d0] = __builtin_amdgcn_mfma_f32_32x32x16_bf16(__builtin_bit_cast(bf16x8, pw[ks]), vf, o[d0], 0, 0, 0);
            if (ks == 3) __builtin_amdgcn_sched_barrier(0);
        }
}

struct AttnP { const bf16_t* Q; const unsigned char* KV; const bf16_t* KC; const bf16_t* VC; const float* GN; bf16_t* ZB; };

template <int MODE>
__device__ __forceinline__ void attn_branch(const AttnP& P, LAS unsigned char* lds, int b, int g, int i, unsigned tilemask, unsigned selmask,
                                            const bf16x8* qr, float slope2, int a, f32x16* oacc, float gate, LAS float* wsf, u32x4 kreg, u32x4 vreg) {
    const int tid = threadIdx.x, lane = tid & 63, r32 = lane & 31, hi = lane >> 5; const int wid = __builtin_amdgcn_readfirstlane(tid >> 6);
    const bf16_t* Kg = (const bf16_t*)(P.KV + (size_t)(MODE == 1 ? 2 : 4) * KVARR) + (size_t)b * T * 256 + g * 64;
    const bf16_t* Vg = (const bf16_t*)((const unsigned char*)Kg + KVARR);
    const bf16_t* ksrc = Kg + (size_t)lane * 256 + wid * 8;
    const bf16_t* vsrc = Vg + (size_t)(16 * (wid & 3) + (lane >> 2)) * 256 + (wid >> 2) * 32 + (lane & 3) * 8;
    const int stoff = wid * 1024 + lane * 16;
    const unsigned himask = hi ? 0u : 0xffffffffu;
    const float s_hi = bf_lo(cvtpk(slope2, 0.f) & 0xffffu) , s_lo = slope2 - s_hi;
    u32x4 qx; qx.x = cvtpk(s_hi, s_lo) & himask; qx.y = qx.x; qx.z = 0u; qx.w = 0u;
    u32x4 kx0, kx1; kx0.x = cvtpk((float)r32, (float)r32) & himask; kx1.x = cvtpk((float)(r32 + 32), (float)(r32 + 32)) & himask;
    kx0.z = 0x3f803f80u & himask; kx1.z = kx0.z; kx0.w = 0u; kx1.w = 0u;
    f32x16 o[2]; o[0] = f32x16{}; o[1] = f32x16{};
    float m_run = 0.f, l_run = 0.f; unsigned negm_bits = 0u; bool first = true;
    unsigned rem = (unsigned)__builtin_amdgcn_readfirstlane((int)tilemask);
    int j = 31 - __builtin_clz(rem); rem &= ~(1u << j);
    int buf = 0;
    for (;;) {
        *(LAS u32x4*)(lds + L_KB + buf * 8192 + stoff) = kreg; *(LAS u32x4*)(lds + L_VB + buf * 8192 + stoff) = vreg;
        __syncthreads();
        int jn = -1;
        if (rem) { jn = 31 - __builtin_clz(rem); rem &= ~(1u << jn); kreg = *(const u32x4*)(ksrc + (size_t)jn * 64 * 256); vreg = *(const u32x4*)(vsrc + (size_t)jn * 64 * 256); }
        { const float tb = (float)(64 * (j - i)); kx0.y = cvtpk(tb, tb) & himask; kx1.y = kx0.y; }
        f32x16 p0, p1; float ls = 0.f; bool need = first;
#pragma unroll 1
        for (int pass = 0; pass < 2; ++pass) {
            qx.z = negm_bits | ((MODE == 1 && !((selmask >> j) & 1u)) ? (0x0000f14au & himask) : 0u);
            p0 = __builtin_amdgcn_mfma_f32_32x32x16_bf16(__builtin_bit_cast(bf16x8, kx0), __builtin_bit_cast(bf16x8, qx), f32x16{}, 0, 0, 0);
            p1 = __builtin_amdgcn_mfma_f32_32x32x16_bf16(__builtin_bit_cast(bf16x8, kx1), __builtin_bit_cast(bf16x8, qx), f32x16{}, 0, 0, 0);
            qk_tile(p0, p1, lds + L_KB + buf * 8192, qr, r32, hi);
            if (j == i || (MODE == 2 && j == i - 8)) {
                int lo2 = (j == i ? 0 : a + 1) - 4 * hi, hb2 = (j == i ? a : 63) - 4 * hi; asm volatile("" : "+v"(lo2), "+v"(hb2));
#pragma unroll
                for (int r = 0; r < 16; ++r) { const int cr = (r & 3) + 8 * (r >> 2); if (cr < lo2 || cr > hb2) p0[r] = -1e30f; if (cr + 32 < lo2 || cr + 32 > hb2) p1[r] = -1e30f; }
            }
            if (need) {
                float mx = fmaxf(fmaxf(p0[0], p0[1]), p0[2]);
#pragma unroll
                for (int r = 3; r < 15; r += 2) mx = fmaxf(fmaxf(mx, p0[r]), p0[r + 1]);
                mx = fmaxf(fmaxf(mx, p0[15]), p1[0]);
#pragma unroll
                for (int r = 1; r < 15; r += 2) mx = fmaxf(fmaxf(mx, p1[r]), p1[r + 1]);
                mx = fmaxf(mx, p1[15]);
                mx = fmaxf(mx, __shfl_xor(mx, 32));
                if (first || __any(mx > 8.f)) {
                    const float dd = first ? (mx > -1e29f ? mx : 0.f) : fmaxf(mx, 0.f);
                    const unsigned mb = cvtpk(m_run + dd, 0.f) & 0xffffu; const float m_new = bf_lo(mb); const float delta = m_new - m_run;
#pragma unroll
                    for (int r = 0; r < 16; ++r) { p0[r] -= delta; p1[r] -= delta; }
                    if (!first) { const float f = __builtin_amdgcn_exp2f(-delta); l_run *= f;
                        if (hi == 0) wsf[r32] = f;
                        asm volatile("" ::: "memory");
#pragma unroll
                        for (int r = 0; r < 16; ++r) { const float fr_ = wsf[crow(r, hi)]; o[0][r] *= fr_; o[1][r] *= fr_; } }
                    m_run = m_new; negm_bits = (m_new == 0.f) ? 0u : (((mb ^ 0x8000u) << 16) & himask); first = false;
                }
            }
            ls = 0.f;
#pragma unroll
            for (int r = 0; r < 16; ++r) { p0[r] = __builtin_amdgcn_exp2f(p0[r]); p1[r] = __builtin_amdgcn_exp2f(p1[r]); ls += p0[r] + p1[r]; }
            if (need || !__any(!(ls <= 256.f))) break;
            need = true;
        }
        l_run += ls;
        if (__any(ls > 0.f)) pv_tile(o, lds + L_VB + buf * 8192, lane, hi, p0, p1);
        if (jn < 0) break;
        j = jn; buf ^= 1;
    }
    const float lt = l_run + __shfl_xor(l_run, 32);
    const float coef = lt > 0.f ? gate / lt : 0.f;
    asm volatile("" ::: "memory");
    if (hi == 0) wsf[32 + r32] = coef;
    asm volatile("" ::: "memory");
#pragma unroll
    for (int r = 0; r < 16; ++r) { const float cf = wsf[32 + crow(r, hi)]; oacc[0][r] += o[0][r] * cf; oacc[1][r] += o[1][r] * cf; }
    asm volatile("" : "+v"(oacc[0]), "+v"(oacc[1]));
    __syncthreads();
}


template <int MODE>
__device__ __forceinline__ void attn_first_tile(const AttnP& P, int b, int g, int i, u32x4& kreg, u32x4& vreg) {
    const int tid = threadIdx.x, lane = tid & 63; const int wid = __builtin_amdgcn_readfirstlane(tid >> 6);
    const bf16_t* Kg = (const bf16_t*)(P.KV + (size_t)(MODE == 1 ? 2 : 4) * KVARR) + (size_t)b * T * 256 + g * 64;
    const bf16_t* Vg = (const bf16_t*)((const unsigned char*)Kg + KVARR);
    kreg = *(const u32x4*)(Kg + (size_t)(64 * i + lane) * 256 + wid * 8);
    vreg = *(const u32x4*)(Vg + (size_t)(64 * i + 16 * (wid & 3) + (lane >> 2)) * 256 + (wid >> 2) * 32 + (lane & 3) * 8);
}


__device__ __forceinline__ void glds16(const void* gsrc, unsigned lds_dst) { unsigned keep;
    asm volatile("s_mov_b32 %0, m0\n\ts_mov_b32 m0, %2\n\ts_nop 0\n\tglobal_load_lds_dwordx4 %1, off\n\ts_mov_b32 m0, %0" : "=&s"(keep) : "v"(gsrc), "s"(lds_dst) : "memory"); }
__device__ __forceinline__ void attn_prefetch(const AttnP& P, LAS unsigned char* lds, int b, int g, int i) {
    const int tid = threadIdx.x, lane = tid & 63; const int wid = __builtin_amdgcn_readfirstlane(tid >> 6);
    const int hr = wid >> 1, qh = wid & 1, h = 4 * g + hr;
    const unsigned l0 = (unsigned)(size_t)lds;
    const bf16_t* qsrc = P.Q + ((size_t)b * T + 64 * i + 32 * qh + (lane >> 3)) * 1024 + h * 64 + (lane & 7) * 8;
#pragma unroll
    for (int k = 0; k < 4; ++k) glds16(qsrc + (size_t)k * 8 * 1024, (unsigned)__builtin_amdgcn_readfirstlane((int)(l0 + L_QN + wid * 4096 + k * 1024)));
    const bf16_t* kcb = P.KC + (size_t)(b * 4 + g) * 128 * 64; const bf16_t* vcb = P.VC + (size_t)(b * 4 + g) * 128 * 64;
#pragma unroll
    for (int tt = 0; tt < 2; ++tt) {
        glds16(kcb + (size_t)(tt * 64 + lane) * 64 + wid * 8, (unsigned)__builtin_amdgcn_readfirstlane((int)(l0 + L_KC + tt * 8192 + wid * 1024)));
        glds16(vcb + (size_t)(tt * 64 + 16 * (wid & 3) + (lane >> 2)) * 64 + (wid >> 2) * 32 + (lane & 3) * 8, (unsigned)__builtin_amdgcn_readfirstlane((int)(l0 + L_VC + tt * 8192 + wid * 1024)));
    }
}

__device__ __forceinline__ void attn_unit(const AttnP& P, LAS unsigned char* lds, int b, int g, int i, bool has_next, int nb, int ng, int ni) {
    const int tid = threadIdx.x, lane = tid & 63, r32 = lane & 31, hi = lane >> 5; const int wid = __builtin_amdgcn_readfirstlane(tid >> 6);
    const int hr = wid >> 1, qh = wid & 1, h = 4 * g + hr, a = 32 * qh + r32, t = 64 * i + a;
    const size_t rowq = (size_t)b * T + t;
    const float slope2 = exp2f(-0.5f * (float)(h + 1)) * LOG2E;
    asm volatile("s_waitcnt vmcnt(0)" ::: "memory");
    if (tid == 0) *(LAS unsigned*)(lds + L_SELU) = 0u;
    __syncthreads();
    bf16x8 qr[4];
#pragma unroll
    for (int d0 = 0; d0 < 4; ++d0) qr[d0] = *(const LAS bf16x8*)(lds + L_QN + wid * 4096 + r32 * 128 + d0 * 32 + hi * 16);
    const float g_cmp = P.GN[rowq * 48 + h * 3 + 0], g_slc = P.GN[rowq * 48 + h * 3 + 1], g_win = P.GN[rowq * 48 + h * 3 + 2];
    LAS float* wsf = (LAS float*)(lds + L_WSF) + wid * 64;
    u32x4 k1, v1; attn_first_tile<1>(P, b, g, i, k1, v1);
    f32x16 oacc[2]; oacc[0] = f32x16{}; oacc[1] = f32x16{};
    {
        f32x16 p[4];
#pragma unroll
        for (int ct = 0; ct < 4; ++ct) p[ct] = f32x16{};
        qk_tile(p[0], p[1], lds + L_KC, qr, r32, hi);
        const bool two = (4 * i + 3) > 64;
        if (two) qk_tile(p[2], p[3], lds + L_KC + 8192, qr, r32, hi);
        float mx = -1e30f;
#pragma unroll
        for (int ct = 0; ct < 4; ++ct)
#pragma unroll
            for (int r = 0; r < 16; ++r) { const int c = 32 * ct + crow(r, hi); const int dist = t - 31 - 16 * c;
                const float s = dist >= 0 ? p[ct][r] - slope2 * (float)dist : -1e30f; p[ct][r] = s; mx = fmaxf(mx, s); }
        mx = fmaxf(mx, __shfl_xor(mx, 32));
        float ls = 0.f;
#pragma unroll
        for (int ct = 0; ct < 4; ++ct)
#pragma unroll
            for (int r = 0; r < 16; ++r) { const float e = p[ct][r] > -1e29f ? __builtin_amdgcn_exp2f(p[ct][r] - mx) : 0.f; p[ct][r] = e; ls += e; }
        ls += __shfl_xor(ls, 32);
        const float inv = ls > 0.f ? 1.f / ls : 0.f;
#pragma unroll
        for (int ct = 0; ct < 4; ++ct)
#pragma unroll
            for (int r = 0; r < 16; ++r) p[ct][r] *= inv;
        LAS float* imph = (LAS float*)(lds + L_IMP) + (hr * 64 + a) * 33;
#pragma unroll
        for (int ct = 0; ct < 4; ++ct)
#pragma unroll
            for (int g4 = 0; g4 < 4; ++g4) { const int jj = 8 * ct + 2 * g4 + hi; imph[jj] = (p[ct][4 * g4] + p[ct][4 * g4 + 1]) + (p[ct][4 * g4 + 2] + p[ct][4 * g4 + 3]); }
        asm volatile("s_waitcnt lgkmcnt(0)" ::: "memory");
#pragma unroll
        for (int ct = 0; ct < 4; ++ct)
#pragma unroll
            for (int g4 = 0; g4 < 4; ++g4) { const int jj = 8 * ct + 2 * g4 + hi; imph[jj + 1] += p[ct][4 * g4 + 3]; asm volatile("" ::: "memory"); }
        f32x16 o[2]; o[0] = f32x16{}; o[1] = f32x16{};
        pv_tile(o, lds + L_VC, lane, hi, p[0], p[1]);
        if (two) pv_tile(o, lds + L_VC + 8192, lane, hi, p[2], p[3]);
        if (hi == 0) wsf[32 + r32] = g_cmp;
        asm volatile("" ::: "memory");
#pragma unroll
        for (int r = 0; r < 16; ++r) { const float cf = wsf[32 + crow(r, hi)]; oacc[0][r] += o[0][r] * cf; oacc[1][r] += o[1][r] * cf; }
        asm volatile("" : "+v"(oacc[0]), "+v"(oacc[1]));
    }
    __syncthreads();
    {
        const int qa = tid >> 3, sub = tid & 7;
        unsigned sel;
        if (i <= 7) sel = (2u << i) - 1u;
        else {
            const LAS float* I0 = (const LAS float*)(lds + L_IMP) + qa * 33 + 4 * sub;
            float v[4];
#pragma unroll
            for (int k = 0; k < 4; ++k) { const int jj = 4 * sub + k; const float sum = ((I0[k] + I0[k + 64 * 33]) + I0[k + 2 * 64 * 33]) + I0[k + 3 * 64 * 33]; v[k] = (jj >= 1 && jj <= i - 2) ? sum : -2.f; }
            sel = 1u | (1u << i) | (1u << (i - 1));
            for (int k5 = 0; k5 < 5; ++k5) {
                float bv = -1.f; int bj = 64;
#pragma unroll
                for (int k = 0; k < 4; ++k) if (v[k] > bv) { bv = v[k]; bj = 4 * sub + k; }
#pragma unroll
                for (int off = 1; off < 8; off <<= 1) {
                    const int bvi = __builtin_bit_cast(int, bv); const bool lowq = (tid & 4) == 0;
                    const float pv_ = __builtin_bit_cast(float, off == 1 ? dpp_x1(bvi) : off == 2 ? dpp_x2(bvi) : dpp_x4(bvi, lowq));
                    const int pj = off == 1 ? dpp_x1(bj) : off == 2 ? dpp_x2(bj) : dpp_x4(bj, lowq);
                    if (pv_ > bv || (pv_ == bv && pj < bj)) { bv = pv_; bj = pj; } }
                sel |= 1u << (bj & 31);
#pragma unroll
                for (int k = 0; k < 4; ++k) if (bj == 4 * sub + k) v[k] = -2.f;
            }
        }
        if (sub == 0) { ((LAS unsigned*)(lds + L_SEL))[qa] = sel; if ((tid & 63) == 0) {   } }
        unsigned un = sel;
#pragma unroll
        for (int off = 8; off < 64; off <<= 1) un |= __shfl_xor(un, off);
        if ((tid & 63) == 0) atomicOr((unsigned*)(LAS unsigned*)(lds + L_SELU), un);
    }
    __syncthreads();
    const unsigned selmask = ((LAS unsigned*)(lds + L_SEL))[a];
    const unsigned uni = *(LAS unsigned*)(lds + L_SELU);
    u32x4 k2, v2; attn_first_tile<2>(P, b, g, i, k2, v2);
    attn_branch<1>(P, lds, b, g, i, uni, selmask, qr, slope2, a, oacc, g_slc, wsf, k1, v1);
    if (has_next) attn_prefetch(P, lds, nb, ng, ni);
    const unsigned wmask = (i >= 8) ? (0x1ffu << (i - 8)) : ((2u << i) - 1u);
    attn_branch<2>(P, lds, b, g, i, wmask, 0u, qr, slope2, a, oacc, g_win, wsf, k2, v2);
    {
        LAS float* stg = (LAS float*)(lds + (wid < 4 ? L_KB + wid * 8192 : L_IMP + (wid - 4) * 8192));
#pragma unroll
        for (int r = 0; r < 16; ++r) { const int orow = crow(r, hi);
#pragma unroll
            for (int d0 = 0; d0 < 2; ++d0) stg[orow * 64 + d0 * 32 + r32] = oacc[d0][r]; }
        asm volatile("s_waitcnt lgkmcnt(0)" ::: "memory");
        bf16_t* zb = P.ZB + ((size_t)b * T + 64 * i + 32 * qh) * 1024 + h * 64;
#pragma unroll
        for (int q4 = 0; q4 < 4; ++q4) { const int row = q4 * 8 + (lane >> 3), ch = lane & 7;
            const f32x4 o0 = *(const LAS f32x4*)(stg + row * 64 + ch * 8), o1 = *(const LAS f32x4*)(stg + row * 64 + ch * 8 + 4);
            bf16_t* zp = zb + (size_t)row * 1024 + ch * 8; const u32x4 zv = *(const u32x4*)zp; u32x4 w;
            w.x = cvtpk(o0[0] * bf_lo(zv.x), o0[1] * bf_hi(zv.x)); w.y = cvtpk(o0[2] * bf_lo(zv.y), o0[3] * bf_hi(zv.y));
            w.z = cvtpk(o1[0] * bf_lo(zv.z), o1[1] * bf_hi(zv.z)); w.w = cvtpk(o1[2] * bf_lo(zv.w), o1[3] * bf_hi(zv.w));
            *(u32x4*)zp = w; }
    }
}

#define XB_TMO      128
#define XB_XCNT(j)  (256  + 64 * (j))
#define XB_XSUB(j)  (1280 + 64 * (j))
#define XB_XGEN(j)  (2304 + 64 * (j))
#define XB_TOP      3328
#define XB_TOPGEN   3392
#define XCD_BAR_WORDS 3456
#define XB_SPIN_CAP (1u << 18)
__device__ __forceinline__ unsigned xb_ld(unsigned* p)              { return __hip_atomic_load(p, __ATOMIC_RELAXED, __HIP_MEMORY_SCOPE_AGENT); }
__device__ __forceinline__ unsigned xb_add(unsigned* p, unsigned v) { return __hip_atomic_fetch_add(p, v, __ATOMIC_RELAXED, __HIP_MEMORY_SCOPE_AGENT); }
__device__ __forceinline__ unsigned xb_xcc_id() { return (unsigned)__builtin_amdgcn_s_getreg((3 << 11) | 20) & 0xFu; }
#define XB_SPIN(cond, bar) do { unsigned _sp = 0; while (cond) { __builtin_amdgcn_s_sleep(1); \
    if ((++_sp & 255u) == 0u) { if (xb_ld(&(bar)[XB_TMO])) break; if (_sp > XB_SPIN_CAP) { atomicAdd(&(bar)[XB_TMO], 1u); break; } } } } while (0)
struct XcdBarrier { unsigned* bar; unsigned x; volatile LAS unsigned* st; };
__device__ __forceinline__ XcdBarrier xcd_barrier_post(unsigned* bar, volatile LAS unsigned* st) {
    XcdBarrier b; b.bar = bar; b.x = xb_xcc_id(); b.st = st;
    if (threadIdx.x == 0) (void)xb_add(&bar[XB_XCNT(b.x)], 1u);
    return b;
}
__device__ __forceinline__ void xcd_barrier_complete(unsigned* bar, unsigned x, unsigned& nloc, unsigned& nx) {
    const unsigned G = gridDim.x * gridDim.y * gridDim.z;
    unsigned sum, cnt, mine, sp = 0u;
    for (;;) {
        sum = 0u; cnt = 0u; mine = 0u;
#pragma unroll
        for (unsigned j = 0; j < 16; ++j) { const unsigned c = xb_ld(&bar[XB_XCNT(j)]); sum += c; cnt += (c > 0u) ? 1u : 0u; mine = (j == x) ? c : mine; }
        if (sum == G) break;
        __builtin_amdgcn_s_sleep(1);
        if ((++sp & 255u) == 0u) { if (xb_ld(&bar[XB_TMO])) break; if (sp > XB_SPIN_CAP) { atomicAdd(&bar[XB_TMO], 1u); break; } }
    }
    nloc = mine > 0u ? mine : 1u; nx = cnt > 0u ? cnt : 1u;
}
__device__ __forceinline__ void xcd_barrier(const XcdBarrier& b) {
    asm volatile("s_waitcnt vmcnt(0)" ::: "memory");
    __syncthreads();
    if (threadIdx.x == 0) {
        unsigned* bar = b.bar;
        __builtin_amdgcn_s_waitcnt(0);
        unsigned nloc = b.st[0], nx = b.st[1];
        if (nloc == 0u) { xcd_barrier_complete(bar, b.x, nloc, nx); b.st[0] = nloc; b.st[1] = nx; }
        const unsigned old = xb_add(&bar[XB_XSUB(b.x)], 1u);
        const unsigned gen = old / nloc;
        if (old + 1u == (gen + 1u) * nloc) {
            __builtin_amdgcn_fence(__ATOMIC_RELEASE, "agent");
            asm volatile("s_waitcnt vmcnt(0)" ::: "memory");
            const unsigned og = xb_add(&bar[XB_TOP], 1u);
            const unsigned tg = og / nx;
            if (og + 1u == (tg + 1u) * nx) xb_add(&bar[XB_TOPGEN], 1u);
            else XB_SPIN(xb_ld(&bar[XB_TOPGEN]) == tg, bar);
            __builtin_amdgcn_fence(__ATOMIC_ACQUIRE, "agent");
            xb_add(&bar[XB_XGEN(b.x)], 1u);
            asm volatile("s_waitcnt vmcnt(0)" ::: "memory");
        } else {
            XB_SPIN(xb_ld(&bar[XB_XGEN(b.x)]) == gen, bar);
            __builtin_amdgcn_fence(__ATOMIC_ACQUIRE, "agent");
            asm volatile("s_waitcnt vmcnt(0)" ::: "memory");
        }
    }
    __syncthreads();
}


struct GrpBar { unsigned* sub; unsigned* gen; unsigned n; bool local; };
__device__ __forceinline__ void grp_barrier(const GrpBar& gb) {
    asm volatile("s_waitcnt vmcnt(0)" ::: "memory");
    __syncthreads();
    if (threadIdx.x == 0) {
        __builtin_amdgcn_s_waitcnt(0);
        if (!gb.local) { __builtin_amdgcn_fence(__ATOMIC_RELEASE, "agent"); asm volatile("s_waitcnt vmcnt(0)" ::: "memory"); }
        const unsigned old = xb_add(gb.sub, 1u); const unsigned gen = old / gb.n;
        if (old + 1u == (gen + 1u) * gb.n) xb_add(gb.gen, 1u);
        else { unsigned sp = 0; while (xb_ld(gb.gen) == gen) { __builtin_amdgcn_s_sleep(1); if (++sp > (1u << 24)) break; } }
        __builtin_amdgcn_fence(__ATOMIC_ACQUIRE, "agent");
        asm volatile("s_waitcnt vmcnt(0)" ::: "memory");
    }
    __syncthreads();
}

struct Args { const float* in[15]; float* out; unsigned char* ws; };

__global__ void __launch_bounds__(512, 2) fwd_kernel(Args args) {
    extern __shared__ __attribute__((aligned(16))) unsigned char lds_raw[];
    LAS unsigned char* lds = (LAS unsigned char*)lds_raw;
    cg::grid_group grid = cg::this_grid();
    const int tid = threadIdx.x, lane = tid & 63, wave = __builtin_amdgcn_readfirstlane(tid >> 6);
    const int G = gridDim.x, bx = blockIdx.x; const int vcu = (G % 8 == 0) ? (bx % 8) * (G / 8) + bx / 8 : bx;
    const int gw = vcu * 8 + wave, NGW = G * 8;
    unsigned char* ws = args.ws; unsigned char* dout = (unsigned char*)args.out;
    const float* x = args.in[0]; const float* norm_w = args.in[1]; const float* w_in = args.in[2]; const float* conv_w = args.in[3]; const float* conv_b = args.in[4];
    const float* pe_k = args.in[5]; const float* pe_v = args.in[6]; const float* w1_k = args.in[7]; const float* w2_k = args.in[8]; const float* w1_v = args.in[9]; const float* w2_v = args.in[10];
    const float* w_pa = args.in[11]; const float* w_pb = args.in[12]; const float* w_o = args.in[13]; const float* fnw = args.in[14];
    bf16_t* WINT = (bf16_t*)(ws + WS_WINT);
    volatile LAS unsigned* xst = (volatile LAS unsigned*)(lds + LDS_BYTES - 64);
    if (tid < 2) xst[tid] = 0u;
    __syncthreads();
    XcdBarrier xbar = xcd_barrier_post((unsigned*)ws, xst);
    if (ws == nullptr) grid.sync();
#define GRID_BAR() xcd_barrier(xbar)
    if (tid == 0) __hip_atomic_store((unsigned*)ws + 9216 + bx, xb_xcc_id() + 1u, __ATOMIC_RELAXED, __HIP_MEMORY_SCOPE_AGENT);
    GrpBar gbar; gbar.sub = (unsigned*)ws + 8192 + 64 * (bx & 7); gbar.gen = (unsigned*)ws + 8704 + 64 * (bx & 7); gbar.n = (unsigned)(G / 8); gbar.local = false;
    const bool use_grp = (G == 256);
#define GROUP_BAR() do { if (use_grp) grp_barrier(gbar); else xcd_barrier(xbar); } while (0)

    {
        LAS float* scr = (LAS float*)(lds + wave * 16640);
        constexpr int NB_IN = (NIN + 63) / 64, I_IN = 16 * NB_IN, I_SQ = 16 * 16, I_W1 = 32 * 2;
        constexpr int NITEMS = I_IN + 3 * I_SQ + 3 * I_W1;
        for (int it = gw; it < NITEMS; it += NGW) {
            int r = it;
            if (r < I_IN) { transpose_item64(w_in, NIN, NIN, 1024, NB_IN, WINT, scr, r, lane, RowIn{}); continue; } r -= I_IN;
            if (r < I_SQ) { transpose_item64(w_pa, 1024, 1024, 1024, 16, (bf16_t*)(ws + WS_WA), scr, r, lane, RowOff{0}); continue; } r -= I_SQ;
            if (r < I_SQ) { transpose_item64(w_pb, 1024, 1024, 1024, 16, (bf16_t*)(ws + WS_WB), scr, r, lane, RowOff{0}); continue; } r -= I_SQ;
            if (r < I_SQ) { transpose_item64(w_o, 1024, 1024, 1024, 16, (bf16_t*)(ws + WS_WO), scr, r, lane, RowOff{0}); continue; } r -= I_SQ;
            if (r < I_W1) { transpose_item64(w1_k, 128, 128, 2048, 2, (bf16_t*)(ws + WS_W1S), scr, r, lane, RowOff{0}); continue; } r -= I_W1;
            if (r < I_W1) { transpose_item64(w1_v, 128, 128, 2048, 2, (bf16_t*)(ws + WS_W1S), scr, r, lane, RowOff{128}); continue; } r -= I_W1;
            transpose_item64(w1_k, 128, 128, 2048, 2, (bf16_t*)(ws + WS_W1S), scr, r, lane, RowOff{256});
        }
        for (int q = bx * 512 + tid; q < 208 * 128; q += G * 512) *(u32x4*)(WINT + (size_t)(38 * 256 + 48 + (q >> 7)) * 1024 + (q & 127) * 8) = (u32x4){0u, 0u, 0u, 0u};
        if (gw < 256) {
            const int kvs = gw >> 7, hid = gw & 127; const float* pe = kvs ? pe_v : pe_k; const float* w1 = kvs ? w1_v : w1_k; float s = 0.f;
            for (int kk = lane; kk < 2048; kk += 64) s += pe[kk] * w1[(size_t)kk * 128 + hid];
            s = wave_sum(s);
            if (lane == 0) ((float*)(ws + WS_PEB))[gw] = s;
        }
    }
    unsigned* arrw = (unsigned*)ws + 12288;
    asm volatile("s_waitcnt vmcnt(0)" ::: "memory");
    __syncthreads();
    if (tid == 0) { __builtin_amdgcn_fence(__ATOMIC_RELEASE, "agent"); asm volatile("s_waitcnt vmcnt(0)" ::: "memory"); __hip_atomic_fetch_add(arrw, 1u, __ATOMIC_RELAXED, __HIP_MEMORY_SCOPE_AGENT); }
    {
        const int nrow = use_grp ? 8 : (M + NGW - 1) / NGW;
        for (int k2 = 0; k2 < nrow; k2 += 2) {
            int m, m2;
            if (use_grp) { m = (bx & 7) * T + (bx >> 3) * 64 + wave * 8 + k2; m2 = m + 1; }
            else { m = gw + k2 * NGW; m2 = m + NGW; if (m >= M) break; if (m2 >= M) m2 = m; }
            const f32x4* xr = (const f32x4*)(x + (size_t)m * D) + lane; const f32x4* xr2 = (const f32x4*)(x + (size_t)m2 * D) + lane; f32x4 v[4], v2[4]; float s = 0.f, s2 = 0.f;
#pragma unroll
            for (int j = 0; j < 4; ++j) { v[j] = xr[64 * j]; v2[j] = xr2[64 * j]; }
#pragma unroll
            for (int j = 0; j < 4; ++j) { s += (v[j].x * v[j].x + v[j].y * v[j].y) + (v[j].z * v[j].z + v[j].w * v[j].w); s2 += (v2[j].x * v2[j].x + v2[j].y * v2[j].y) + (v2[j].z * v2[j].z + v2[j].w * v2[j].w); }
#pragma unroll
            for (int o = 1; o < 64; o <<= 1) { s += __shfl_xor(s, o); s2 += __shfl_xor(s2, o); }
            const float rs = 1.0f / sqrtf(s * (1.f / D) + NORM_EPS), rs2 = 1.0f / sqrtf(s2 * (1.f / D) + NORM_EPS);
            u32x2* o8 = (u32x2*)(dout + (size_t)(m >> 11) * DO_BATCH + (size_t)(m & 2047) * 2048) + lane; u32x2* o82 = (u32x2*)(dout + (size_t)(m2 >> 11) * DO_BATCH + (size_t)(m2 & 2047) * 2048) + lane;
#pragma unroll
            for (int j = 0; j < 4; ++j) { const f32x4 w = ((const f32x4*)norm_w)[lane + 64 * j]; u32x2 o; o.x = cvtpk(v[j].x * rs * w.x, v[j].y * rs * w.y); o.y = cvtpk(v[j].z * rs * w.z, v[j].w * rs * w.w); o8[64 * j] = o;
                u32x2 o2; o2.x = cvtpk(v2[j].x * rs2 * w.x, v2[j].y * rs2 * w.y); o2.y = cvtpk(v2[j].z * rs2 * w.z, v2[j].w * rs2 * w.w); o82[64 * j] = o2; }
        }
    }
    if (tid == 0) { unsigned sp = 0; while (__hip_atomic_load(arrw, __ATOMIC_RELAXED, __HIP_MEMORY_SCOPE_AGENT) < (unsigned)G) { __builtin_amdgcn_s_sleep(2); if (++sp > (1u << 24)) break; }
        __builtin_amdgcn_fence(__ATOMIC_ACQUIRE, "agent"); asm volatile("s_waitcnt vmcnt(0)" ::: "memory"); }
    __syncthreads();
    if (use_grp) {
        volatile LAS unsigned* flagw = xst + 2;
        if (tid < 64) { const unsigned mine = xb_xcc_id() + 1u; const unsigned v = (tid < 32) ? __hip_atomic_load((unsigned*)ws + 9216 + (bx & 7) + 8 * tid, __ATOMIC_RELAXED, __HIP_MEMORY_SCOPE_AGENT) : mine;
            const bool ok = __all(v == mine) != 0; if (tid == 0) *flagw = ok ? 1u : 0u; }
        __syncthreads();
        gbar.local = (*flagw != 0u);
    }

    GROUP_BAR();

    {
        pg8::Gemm g{(const char*)dout, (const char*)WINT, 16, 2048u, 2048u, 128u * 2048u, 128u * 2048u, 128u, 128u};
        pg8::StaticOrder S; S.init(M, NPAD, G, bx, (size_t)256 * 2048, (size_t)256 * 2048, DO_BATCH);
        EpiProj E{ws, conv_w, conv_b};
        const int rounds_full = S.nwg / G, tail = S.nwg - rounds_full * G;
        const bool split = use_grp && tail != 0 && (tail % 8) == 0 && (G - tail) >= 64;
        if (split) S.lim = rounds_full * G;
        pg8::gemm_phase<EpiProj, pg8::StaticOrder, true>(lds, g, S, E);
        GROUP_BAR();
        const bool has_tail = split && bx < tail;
        if (has_tail) { S.i0 = rounds_full; S.lim = S.nwg; pg8::gemm_phase<EpiProj, pg8::StaticOrder, true>(lds, g, S, E); }
        else {
            const int FG = split ? G - tail : G, fbx = split ? bx - tail : bx;
            pg8::Gemm g2{(const char*)(ws + WS_KV), (const char*)(ws + WS_W1S), 16, 8192u, 4096u, 128u, 128u * 4096u, 512u, 128u};
            pg8::CmpOrder S2{FG, fbx};
            EpiCmp E2{(float*)dout};
            pg8::gemm_phase<EpiCmp, pg8::CmpOrder, false>(lds, g2, S2, E2);
            const bf16_t* UC = (const bf16_t*)(ws + WS_UC); bf16_t* GT = (bf16_t*)(ws + WS_GATE);
            for (int idx = fbx * 512 + tid; idx < (M / 32) * 128; idx += FG * 512) {
                const int vb = idx >> 9, b = vb & 7, item = (vb >> 3) * 512 + (idx & 511);
                const int rl = item >> 7, c8 = (item & 127) * 8; const int run = b * 32 + (rl >> 1), q = rl & 1; const int row = run * 64 + q; const bool first = (run & 31) == 0;
                const u32x4 z4 = (u32x4){0u, 0u, 0u, 0u};
                const u32x4 u2 = *(const u32x4*)(UC + (size_t)(run * 4 + q) * 1024 + c8);
                const u32x4 u1 = q ? *(const u32x4*)(UC + (size_t)(run * 4 + 0) * 1024 + c8) : (first ? z4 : *(const u32x4*)(UC + (size_t)((run - 1) * 4 + 3) * 1024 + c8));
                const u32x4 u0 = first ? z4 : *(const u32x4*)(UC + (size_t)((run - 1) * 4 + (q ? 3 : 2)) * 1024 + c8);
                const u32x4 gt = *(const u32x4*)(GT + (size_t)row * 1024 + c8);
                u32x4 ow;
#pragma unroll
                for (int e = 0; e < 4; ++e) {
                    const int c = c8 + 2 * e;
                    const float y0 = conv_b[c] + conv_w[c] * bf_lo(u0[e]) + conv_w[1024 + c] * bf_lo(u1[e]) + conv_w[2048 + c] * bf_lo(u2[e]);
                    const float y1 = conv_b[c + 1] + conv_w[c + 1] * bf_hi(u0[e]) + conv_w[1024 + c + 1] * bf_hi(u1[e]) + conv_w[2048 + c + 1] * bf_hi(u2[e]);
                    ow[e] = cvtpk(bf_lo(gt[e]) * y0, bf_hi(gt[e]) * y1);
                }
                *(u32x4*)(GT + (size_t)row * 1024 + c8) = ow;
            }
        }
    }
    GROUP_BAR();

    {
        if (use_grp) {
            const int b = bx & 7, rbl = bx >> 3, kvs = tid >> 8, t2 = tid & 255; const float* w2 = kvs ? w2_v : w2_k;
            LAS float* W2L = (LAS float*)(lds + kvs * 32768); LAS float* HIDL = (LAS float*)(lds + 65536 + kvs * 8192);
            const float* PARTB = (const float*)(dout + (size_t)b * DO_BATCH + DO_PART);
#pragma unroll
            for (int q4 = 0; q4 < 8; ++q4) ((LAS f32x4*)W2L)[t2 + 256 * q4] = ((const f32x4*)w2)[t2 + 256 * q4];
#pragma unroll
            for (int q2 = 0; q2 < 2; ++q2) { const int idx = t2 + 256 * q2, row = idx >> 5, hc = (idx & 31) * 4; f32x4 s4 = *(const f32x4*)((const float*)(ws + WS_PEB) + kvs * 128 + hc);
#pragma unroll
                for (int ks = 0; ks < 2; ++ks) s4 += *(const f32x4*)(PARTB + ((size_t)(kvs * 2 + ks) * 512 + rbl * 16 + row) * 128 + hc);
                for (int e = 0; e < 4; ++e) s4[e] = silu(s4[e]);
                *(LAS f32x4*)(HIDL + row * 128 + hc) = s4; }
            __syncthreads();
            { const int row = t2 >> 4, d = (t2 & 15) * 4; f32x4 a4 = (f32x4){0.f, 0.f, 0.f, 0.f};
#pragma unroll 8
                for (int jj = 0; jj < 128; ++jj) { const float hv = HIDL[row * 128 + jj]; const f32x4 w = *(LAS f32x4*)(W2L + jj * 64 + d); a4 += w * hv; }
                const int grow = b * 512 + rbl * 16 + row; if ((grow & 127) == 127) a4 = (f32x4){0.f, 0.f, 0.f, 0.f};
                u32x2 o2; o2.x = cvtpk(a4[0], a4[1]); o2.y = cvtpk(a4[2], a4[3]);
                *(u32x2*)((bf16_t*)(ws + (kvs ? WS_VC : WS_KC)) + (size_t)grow * 64 + d) = o2; }
        } else {
        LAS float* W2L = (LAS float*)lds; LAS float* HIDL = (LAS float*)(lds + 32768);
        for (int it = bx; it < 512; it += G) {
            const int b = it & 7, kvs = (it >> 3) >> 5, rbl = (it >> 3) & 31; const float* w2 = kvs ? w2_v : w2_k;
            const float* PARTB = (const float*)(dout + (size_t)b * DO_BATCH + DO_PART);
            __syncthreads();
#pragma unroll
            for (int q4 = 0; q4 < 4; ++q4) ((LAS f32x4*)W2L)[tid + 512 * q4] = ((const f32x4*)w2)[tid + 512 * q4];
            { const int row = tid >> 5, hc = (tid & 31) * 4; f32x4 s = *(const f32x4*)((const float*)(ws + WS_PEB) + kvs * 128 + hc);
#pragma unroll
                for (int ks = 0; ks < 2; ++ks) s += *(const f32x4*)(PARTB + ((size_t)(kvs * 2 + ks) * 512 + rbl * 16 + row) * 128 + hc);
                for (int e = 0; e < 4; ++e) s[e] = silu(s[e]);
                *(LAS f32x4*)(HIDL + row * 128 + hc) = s; }
            __syncthreads();
            { const int row = tid >> 5, d = (tid & 31) * 2; float a0 = 0.f, a1 = 0.f;
#pragma unroll 8
                for (int jj = 0; jj < 128; ++jj) { const float hv = HIDL[row * 128 + jj]; const f32x2 w = *(LAS f32x2*)(W2L + jj * 64 + d); a0 += hv * w.x; a1 += hv * w.y; }
                const int grow = b * 512 + rbl * 16 + row; if ((grow & 127) == 127) { a0 = 0.f; a1 = 0.f; }
                *(unsigned*)((bf16_t*)(ws + (kvs ? WS_VC : WS_KC)) + (size_t)grow * 64 + d) = cvtpk(a0, a1); }
        }
    }
        }
    GROUP_BAR();

    {
        AttnP P{(const bf16_t*)(ws + WS_Q), ws + WS_KV, (const bf16_t*)(ws + WS_KC), (const bf16_t*)(ws + WS_VC), (const float*)(ws + WS_GNSA), (bf16_t*)(ws + WS_ZB)};
#define ATT_DECODE(K_, B_, G_, I_) do { const int slot_ = (K_) >> 8, v_ = (K_) & 255, bg_ = v_ >> 3, s_ = v_ & 7; \
            I_ = slot_ == 0 ? s_ : slot_ == 1 ? 15 - s_ : slot_ == 2 ? 16 + s_ : 31 - s_; B_ = bg_ >> 2; G_ = bg_ & 3; } while (0)
        int k = vcu, ub = 0, ug = 0, ui = 0;
        if (k < 1024) { ATT_DECODE(k, ub, ug, ui); attn_prefetch(P, lds, ub, ug, ui); }
        for (; k < 1024; k += G) {
            const bool has_next = (k + G) < 1024; int nb = 0, ng = 0, ni = 0;
            if (has_next) ATT_DECODE(k + G, nb, ng, ni);
            __syncthreads();
            attn_unit(P, lds, ub, ug, ui, has_next, nb, ng, ni);
            ub = nb; ug = ng; ui = ni;
        }
#undef ATT_DECODE
    }
    GROUP_BAR();

    {
        pg8::PairOrder S; S.so.init(M, 1024, G, bx, (size_t)256 * 2048, (size_t)256 * 2048); S.a0 = WS_GATE; S.a1 = WS_ZB; S.b0 = WS_WA; S.b1 = WS_WB;
        pg8::Gemm g{(const char*)ws, (const char*)ws, 16, 2048u, 2048u, 128u * 2048u, 128u * 2048u, 128u, 128u};
        EpiPair E{(const bf16_t*)(ws + WS_G0), (bf16_t*)(ws + WS_G1)};
        pg8::gemm_phase<EpiPair, pg8::PairOrder, true>(lds, g, S, E);
    }
    GROUP_BAR();

    {
        pg8::StaticOrder S; S.init(M, 1024, G, bx, (size_t)256 * 2048, (size_t)256 * 2048);
        pg8::Gemm g{(const char*)(ws + WS_G1), (const char*)(ws + WS_WO), 16, 2048u, 2048u, 128u * 2048u, 128u * 2048u, 128u, 128u};
        if (G == 256) {
            EpiOutNorm E{x, args.out, fnw, (float*)(ws + WS_X), (unsigned*)ws + 4096};
            pg8::gemm_phase<EpiOutNorm, pg8::StaticOrder, false>(lds, g, S, E);
        } else {
            EpiOut E{x, args.out}; pg8::gemm_phase<EpiOut, pg8::StaticOrder, true>(lds, g, S, E);
            GRID_BAR();
            for (int m = gw; m < M; m += NGW) {
                f32x4* xr = (f32x4*)(args.out + (size_t)m * D) + lane; f32x4 v[4]; float sq = 0.f;
#pragma unroll
                for (int j = 0; j < 4; ++j) { v[j] = xr[64 * j]; sq += (v[j].x * v[j].x + v[j].y * v[j].y) + (v[j].z * v[j].z + v[j].w * v[j].w); }
                const float rs = 1.0f / sqrtf(wave_sum(sq) * (1.f / D) + NORM_EPS);
#pragma unroll
                for (int j = 0; j < 4; ++j) { const f32x4 w = ((const f32x4*)fnw)[lane + 64 * j]; xr[64 * j] = (f32x4){v[j].x * rs * w.x, v[j].y * rs * w.y, v[j].z * rs * w.z, v[j].w * rs * w.w}; }
            }
        }
    }
}

extern "C" void kernel_launch(void* const* d_in, const int* in_sizes, int n_in, void* d_out, int out_size, void* d_ws, size_t ws_size, hipStream_t stream) {
    static int grid = 0;
    if (grid == 0) {
        if (n_in != 15 || out_size != M * D || ws_size < WS_END) { fprintf(stderr, "kernel_launch: unexpected problem (n_in %d, out %d, ws %zu)\n", n_in, out_size, ws_size); grid = -1; return; }
        int dev = 0, cus = 0, per_cu = 0;
        hipGetDevice(&dev); hipDeviceGetAttribute(&cus, hipDeviceAttributeMultiprocessorCount, dev);
        if (hipFuncSetAttribute((const void*)fwd_kernel, hipFuncAttributeMaxDynamicSharedMemorySize, LDS_BYTES) != hipSuccess) { fprintf(stderr, "kernel_launch: hipFuncSetAttribute failed\n"); grid = -1; return; }
        if (hipOccupancyMaxActiveBlocksPerMultiprocessor(&per_cu, (const void*)fwd_kernel, 512, LDS_BYTES) != hipSuccess || per_cu < 1) { fprintf(stderr, "kernel_launch: occupancy query says %d\n", per_cu); per_cu = 1; }
        (void)hipGetLastError();
        grid = cus;
    }
    if (grid < 0) return;
    if (hipMemsetAsync(d_ws, 0, 65536, stream) != hipSuccess) { fprintf(stderr, "kernel_launch: memset of the barrier words failed\n"); return; }
    Args a{};
    for (int i = 0; i < 15; ++i) a.in[i] = (const float*)d_in[i];
    a.out = (float*)d_out; a.ws = (unsigned char*)d_ws;
    void* kargs[] = {&a};
    hipError_t e = hipLaunchCooperativeKernel((const void*)fwd_kernel, dim3(grid), dim3(512), kargs, LDS_BYTES, stream);
    if (e != hipSuccess) fprintf(stderr, "cooperative launch failed: %s (grid %d)\n", hipGetErrorString(e), grid);
}
```
